# Optimizing an MI355X kernel written in HIP

```python
import math
import jax, jax.numpy as jnp
from jax import lax
import numpy as np

D_MODEL = 1024
BATCH = 8
SEQ = 2048
DEPTH = 4

GRID_W = 64
CTX_LEN = 256
N_BRANCH = 4
CHUNK = 128
A_GROUPS = 4
A_GDIM = 64
A_WIDTH = A_GROUPS * A_GDIM
B_WIDTH = 256
CONV_W = 3
C_HEADS = 4
C_HDIM = 64
C_VDIM = 2 * C_HDIM
C_WIDTH = C_HEADS * C_VDIM
D_GROUPS = 4
D_GDIM = 64
D_WIDTH = D_GROUPS * D_GDIM
A_COLS = 2 * A_WIDTH
B_COLS = 3 * B_WIDTH
QK_COLS = C_HEADS * 2 * C_HDIM
V_COLS = C_HEADS * C_VDIM
IN_COLS = A_COLS + B_COLS + 2 * QK_COLS + V_COLS + D_WIDTH
SPLIT_AT = (A_COLS, A_COLS + B_COLS, A_COLS + B_COLS + QK_COLS, A_COLS + B_COLS + 2 * QK_COLS, A_COLS + B_COLS + 2 * QK_COLS + V_COLS)
N_EXPERTS = 16
CAP_FACTOR = 2
EXPERT_HIDDEN = 1024
Q_BLOCK = 128
ROPE_BASE = 10000.0
DN_ALPHA = (2 * DEPTH) ** 0.25
DN_BETA = (8 * DEPTH) ** -0.25
LN_EPS = 1e-5
RMS_EPS = 1e-5

kernel_name = 'hybrid_diffusion_gated_mixers_ec_moe'


def layer_norm(x, g=None, b=None):
    xf = x.astype(jnp.float32)
    mu = jnp.mean(xf, axis=-1, keepdims=True)
    var = jnp.mean(jnp.square(xf - mu), axis=-1, keepdims=True)
    y = (xf - mu) * lax.rsqrt(var + LN_EPS)
    if g is not None:
        y = y * g.astype(jnp.float32) + b.astype(jnp.float32)
    return y.astype(x.dtype)


def adaln_params(cond, w, b):
    m = jax.nn.silu(cond) @ w + b
    return jnp.split(m[..., None, :], 6, axis=-1)


def modulate(x, shift, scale):
    return layer_norm(x) * (1 + scale) + shift


def axial_rope_tables(n):
    rows = n // GRID_W
    t = jnp.arange(rows * GRID_W)
    row = (t // GRID_W).astype(jnp.float32)
    col = (t % GRID_W).astype(jnp.float32)
    half = C_HDIM // 2
    inv = ROPE_BASE ** (-jnp.arange(0, half, 2, dtype=jnp.float32) / half)
    ang = jnp.concatenate([row[:, None] * inv, col[:, None] * inv], axis=-1)
    return jnp.cos(ang), jnp.sin(ang)


def apply_rope(t, cos, sin):
    bsz, n, h, i, d = t.shape
    tp = t.astype(jnp.float32).reshape(bsz, n, h, i, d // 2, 2)
    cs = cos[None, :, None, None, :]
    sn = sin[None, :, None, None, :]
    x1, x2 = tp[..., 0], tp[..., 1]
    out = jnp.stack([x1 * cs - x2 * sn, x1 * sn + x2 * cs], axis=-1)
    return out.reshape(t.shape).astype(t.dtype)


def split_proj(z):
    za, zb, q, k, v, zd = jnp.split(z, SPLIT_AT, axis=-1)
    bsz, n = z.shape[:2]
    q = q.reshape(bsz, n, C_HEADS, 2, C_HDIM)
    k = k.reshape(bsz, n, C_HEADS, 2, C_HDIM)
    v = v.reshape(bsz, n, C_HEADS, C_VDIM)
    return za, zb, q, k, v, zd


def chunk_sgu(za, ln_g, ln_b, w_sp, b_sp):
    z = jax.nn.gelu(za)
    u, v = jnp.split(z, 2, axis=-1)
    v = layer_norm(v, ln_g, ln_b)
    bsz, n, _ = v.shape
    v = v.reshape(bsz, n // CHUNK, CHUNK, A_GROUPS, A_GDIM)
    mix = jnp.einsum('gpq,bcqgd->bcpgd', w_sp, v) + b_sp.T[:, :, None]
    return u * mix.reshape(bsz, n, A_WIDTH)


def short_conv_gate(zb, conv_w):
    gb, gc, xv = jnp.split(zb, 3, axis=-1)
    y = gc * xv
    yp = jnp.pad(y, ((0, 0), (1, 1), (0, 0)))
    conv = yp[:, :-2] * conv_w[0] + yp[:, 1:-1] * conv_w[1] + yp[:, 2:] * conv_w[2]
    return gb * conv


def fourier_mix(zd):
    bsz, n, _ = zd.shape
    zg = zd.astype(jnp.float32).reshape(bsz, n, D_GROUPS, D_GDIM)
    f = jnp.fft.fft2(zg, axes=(1, 3), norm='ortho')
    return jnp.real(f).astype(zd.dtype).reshape(bsz, n, D_WIDTH)


def diff_attention(q, k, v, lam):
    s = jnp.einsum('bqhid,bkhid->bhiqk', q.astype(jnp.float32), k.astype(jnp.float32)) * (C_HDIM ** -0.5)
    p = jax.nn.softmax(s, axis=-1)
    a = p[:, :, 0] - lam * p[:, :, 1]
    return jnp.einsum('bhqk,bkhe->bqhe', a, v.astype(jnp.float32)).astype(v.dtype)


def blocked_diff_attention(q, k, v, lam):
    bsz, n = q.shape[:2]
    nb = n // Q_BLOCK
    qb = jnp.moveaxis(q.reshape(bsz, nb, Q_BLOCK, C_HEADS, 2, C_HDIM), 1, 0)
    out = lax.map(lambda qq: diff_attention(qq, k, v, lam), qb)
    return jnp.moveaxis(out, 0, 1).reshape(bsz, n, C_HEADS, C_VDIM)


def diff_post(o, subln_g, lam_init):
    bsz, n = o.shape[:2]
    of = o.astype(jnp.float32)
    of = of * lax.rsqrt(jnp.mean(of * of, axis=-1, keepdims=True) + RMS_EPS) * subln_g.astype(jnp.float32) * (1.0 - lam_init)
    return of.astype(o.dtype).reshape(bsz, n, C_WIDTH)


def merged_mixers(h, za, zb, yc, zd, sgu_ln_g, sgu_ln_b, w_sp, b_sp, conv_w, w_gate, b_gate, w_pa, w_pb, w_pc, w_pd, w_o):
    ya = chunk_sgu(za, sgu_ln_g, sgu_ln_b, w_sp, b_sp)
    yb = short_conv_gate(zb, conv_w)
    yd = fourier_mix(zd)
    g = jax.nn.sigmoid(h @ w_gate + b_gate)
    ga, gb, gc, gd = jnp.split(g, N_BRANCH, axis=-1)
    m = ga * (ya @ w_pa) + gb * (yb @ w_pb) + gc * (yc @ w_pc) + gd * (yd @ w_pd)
    return m @ w_o


def expert_choice_moe(h, w_router, w_g, w_u, w_d):
    bsz, n, _ = h.shape
    cap = (CAP_FACTOR * n) // N_EXPERTS
    aff = jax.nn.softmax((h @ w_router).astype(jnp.float32), axis=-1)
    gate, idx = lax.top_k(jnp.swapaxes(aff, 1, 2), cap)
    bidx = jnp.arange(bsz)[:, None, None]
    xe = h[bidx, idx]
    hid = jax.nn.silu(jnp.einsum('becd,edf->becf', xe, w_g)) * jnp.einsum('becd,edf->becf', xe, w_u)
    ye = jnp.einsum('becf,efd->becd', hid, w_d) * gate[..., None].astype(h.dtype)
    return jnp.zeros_like(h).at[bidx, idx].add(ye)


def setup_inputs(seed: int = 0) -> dict:
    key = jax.random.key(seed)
    ks = iter(jax.random.split(key, 40))
    L, D, E, F = DEPTH, D_MODEL, N_EXPERTS, EXPERT_HIDDEN

    def nrm(shape, scale):
        return jax.random.normal(next(ks), shape, jnp.float32) * scale

    return {
        'x': nrm((BATCH, SEQ, D), 1.0),
        'c': nrm((BATCH, D), 1.0),
        'ctx': nrm((BATCH, CTX_LEN, D), 1.0),
        'c_ctx': nrm((D,), 1.0),
        'w_ada': nrm((L, D, 6 * D), 0.5 * D ** -0.5),
        'b_ada': nrm((L, 6 * D), 0.01),
        'w_in': nrm((L, D, IN_COLS), D ** -0.5),
        'w_gate': nrm((L, D, N_BRANCH * D), D ** -0.5),
        'b_gate': nrm((L, N_BRANCH * D), 0.01),
        'sgu_ln_g': 1.0 + nrm((L, A_WIDTH), 0.01),
        'sgu_ln_b': nrm((L, A_WIDTH), 0.01),
        'w_sp': nrm((L, A_GROUPS, CHUNK, CHUNK), CHUNK ** -0.5),
        'b_sp': 1.0 + nrm((L, A_GROUPS, CHUNK), 0.01),
        'conv_w': nrm((L, CONV_W, B_WIDTH), CONV_W ** -0.5),
        'lam_q1': nrm((L, C_HDIM), 0.1),
        'lam_k1': nrm((L, C_HDIM), 0.1),
        'lam_q2': nrm((L, C_HDIM), 0.1),
        'lam_k2': nrm((L, C_HDIM), 0.1),
        'subln_g': 1.0 + nrm((L, C_VDIM), 0.01),
        'w_pa': nrm((L, A_WIDTH, D), A_WIDTH ** -0.5),
        'w_pb': nrm((L, B_WIDTH, D), B_WIDTH ** -0.5),
        'w_pc': nrm((L, C_WIDTH, D), C_WIDTH ** -0.5),
        'w_pd': nrm((L, D_WIDTH, D), D_WIDTH ** -0.5),
        'w_o': nrm((L, D, D), DN_BETA * D ** -0.5),
        'ln1_g': 1.0 + nrm((L, D), 0.01),
        'ln1_b': nrm((L, D), 0.01),
        'w_router': nrm((L, D, E), D ** -0.5),
        'w_exp_gate': nrm((L, E, D, F), D ** -0.5),
        'w_exp_up': nrm((L, E, D, F), D ** -0.5),
        'w_exp_down': nrm((L, E, F, D), DN_BETA * F ** -0.5),
        'ln2_g': 1.0 + nrm((L, D), 0.01),
        'ln2_b': nrm((L, D), 0.01),
    }


def reference(x, c, ctx, c_ctx, w_ada, b_ada, w_in, w_gate, b_gate, sgu_ln_g, sgu_ln_b, w_sp, b_sp, conv_w, lam_q1, lam_k1, lam_q2, lam_k2, subln_g, w_pa, w_pb, w_pc, w_pd, w_o, ln1_g, ln1_b, w_router, w_exp_gate, w_exp_up, w_exp_down, ln2_g, ln2_b):
    xl, xc = x, ctx
    n = x.shape[1]
    cos, sin = axial_rope_tables(n)
    for l in range(DEPTH):
        last = l == DEPTH - 1
        lam_init = 0.8 - 0.6 * math.exp(-0.3 * l)
        lam = (jnp.exp(jnp.sum(lam_q1[l].astype(jnp.float32) * lam_k1[l].astype(jnp.float32)))
               - jnp.exp(jnp.sum(lam_q2[l].astype(jnp.float32) * lam_k2[l].astype(jnp.float32))) + lam_init)
        ada_l = adaln_params(c, w_ada[l], b_ada[l])
        ada_c = adaln_params(c_ctx, w_ada[l], b_ada[l])
        mix_w = (sgu_ln_g[l], sgu_ln_b[l], w_sp[l], b_sp[l], conv_w[l], w_gate[l], b_gate[l],
                 w_pa[l], w_pb[l], w_pc[l], w_pd[l], w_o[l])
        moe_w = (w_router[l], w_exp_gate[l], w_exp_up[l], w_exp_down[l])

        hl = modulate(xl, ada_l[0], ada_l[1])
        hc = modulate(xc, ada_c[0], ada_c[1])
        za, zb, q, k, v, zd = split_proj(hl @ w_in[l])
        zca, zcb, qc, kc, vc, zcd = split_proj(hc @ w_in[l])
        q = apply_rope(q, cos, sin)
        k = apply_rope(k, cos, sin)
        k_all = jnp.concatenate([kc, k], axis=1)
        v_all = jnp.concatenate([vc, v], axis=1)
        yc_l = diff_post(blocked_diff_attention(q, k_all, v_all, lam), subln_g[l], lam_init)
        mix_l = merged_mixers(hl, za, zb, yc_l, zd, *mix_w)
        xl = layer_norm(DN_ALPHA * xl + ada_l[2] * mix_l, ln1_g[l], ln1_b[l])

        if not last:
            yc_c = diff_post(diff_attention(qc, kc, vc, lam), subln_g[l], lam_init)
            mix_c = merged_mixers(hc, zca, zcb, yc_c, zcd, *mix_w)
            xc = layer_norm(DN_ALPHA * xc + ada_c[2] * mix_c, ln1_g[l], ln1_b[l])
            hc2 = modulate(xc, ada_c[3], ada_c[4])
            xc = layer_norm(DN_ALPHA * xc + ada_c[5] * expert_choice_moe(hc2, *moe_w), ln2_g[l], ln2_b[l])

        hl2 = modulate(xl, ada_l[3], ada_l[4])
        xl = layer_norm(DN_ALPHA * xl + ada_l[5] * expert_choice_moe(hl2, *moe_w), ln2_g[l], ln2_b[l])
    return xl
```

```cpp
#include <hip/hip_runtime.h>
#include <cstdio>
#include <cstdint>

#ifndef MK_N_LAUNCHES
#define MK_N_LAUNCHES 1
#endif
#ifndef GEMM_FAST
#define GEMM_FAST 0
#endif

#define GAS __attribute__((address_space(1)))
#define LAS __attribute__((address_space(3)))
typedef unsigned short bf16;
typedef short bf16x8 __attribute__((ext_vector_type(8)));
typedef short s16x4 __attribute__((ext_vector_type(4)));
typedef float f32x4 __attribute__((ext_vector_type(4)));
typedef float f32x2 __attribute__((ext_vector_type(2)));
typedef float f32x16 __attribute__((ext_vector_type(16)));
typedef unsigned u32x4 __attribute__((ext_vector_type(4)));
typedef unsigned u32x2 __attribute__((ext_vector_type(2)));

constexpr int D = 1024, NB = 8, SEQ = 2048, CTXL = 256, NL = 4;
constexpr int RL = NB * SEQ, RC = NB * CTXL, R = RL + RC;
constexpr int ZC = 3328, YC = 1280, PC = 4096, M2C = 2048;
constexpr int NE = 16, CAPL = 256, CAPC = 32;
constexpr int HROWS = NE * NB * CAPL + NE * NB * CAPC;
constexpr float LN_EPS = 1e-5f, RMS_EPS = 1e-5f, DN_ALPHA = 1.6817928305074290f;

constexpr size_t MiB = 1u << 20;
constexpr size_t WS_CTL = 0, CTL_ZERO_BYTES = 1 * MiB;
constexpr size_t WS_ADA = 1 * MiB;
constexpr size_t WS_LAM = 2 * MiB;
constexpr size_t WS_ROPE = 3 * MiB;
constexpr size_t WS_FCTX = 4 * MiB;
constexpr size_t WS_AFF = 5 * MiB;
constexpr size_t WS_IDX = 7 * MiB;
constexpr size_t WS_GV = 7 * MiB + 512 * 1024;
constexpr size_t WS_INV = 8 * MiB;
constexpr size_t WS_FLAT = 10 * MiB;
constexpr size_t WS_ZT = 26 * MiB;
constexpr size_t WS_X = 44 * MiB;
constexpr size_t WS_HL = 116 * MiB;
constexpr size_t WS_Y = 152 * MiB;
constexpr size_t WS_R1 = 197 * MiB;
constexpr size_t WS_R2 = 314 * MiB;
constexpr size_t WS_W = 458 * MiB;
constexpr size_t WL_IN = 0, WL_G = 7 * MiB, WL_P = 15 * MiB, WL_O = 19 * MiB, WL_GU = 23 * MiB, WL_D = 87 * MiB, WL_STRIDE = 119 * MiB;
constexpr size_t WS_END = WS_W + 4 * WL_STRIDE;
constexpr int CW_BAR = 4096;

__device__ __forceinline__ unsigned cvt_pk_bf16(float lo, float hi) { unsigned r; asm volatile("v_cvt_pk_bf16_f32 %0, %1, %2" : "=v"(r) : "v"(lo), "v"(hi)); return r; }
__device__ __forceinline__ float bf2f(unsigned short b) { return __uint_as_float((unsigned)b << 16); }
__device__ __forceinline__ float bflo(unsigned w) { return __uint_as_float(w << 16); }
__device__ __forceinline__ float bfhi(unsigned w) { return __uint_as_float(w & 0xffff0000u); }
__device__ __forceinline__ unsigned short f2bf(float f) { return (unsigned short)(cvt_pk_bf16(f, 0.f) & 0xffffu); }
__device__ __forceinline__ float wave_sum(float v) {
#pragma unroll
    for (int o = 1; o < 64; o <<= 1) v += __shfl_xor(v, o);
    return v;
}
__device__ __forceinline__ int wave_sum_i(int v) {
#pragma unroll
    for (int o = 1; o < 64; o <<= 1) v += __shfl_xor(v, o);
    return v;
}
__device__ __forceinline__ float sigmoid_f(float x) { return __builtin_amdgcn_rcpf(1.f + __expf(-x)); }
__device__ __forceinline__ float gelu_tanh(float x) { const float y = 0.7978845608028654f * (x + 0.044715f * x * x * x); return x * sigmoid_f(2.f * y); }
#define LDS_WAIT() asm volatile("s_waitcnt lgkmcnt(0)" ::: "memory")
#define VM_WAIT() asm volatile("s_waitcnt vmcnt(0)" ::: "memory")

__device__ __forceinline__ int tid_opaque(int wv) { unsigned z = 0u; asm volatile("" : "+v"(z)); return wv * 64 + (int)__builtin_amdgcn_mbcnt_hi(~0u, __builtin_amdgcn_mbcnt_lo(~0u, z)); }
#define XB_TMO      128
#define XB_XCNT(j)  (256  + 64 * (j))
#define XB_XSUB(j)  (1280 + 64 * (j))
#define XB_XGEN(j)  (2304 + 64 * (j))
#define XB_TOP      3328
#define XB_TOPGEN   3392
#define XCD_BAR_WORDS 3456
#define XB_SPIN_CAP (1u << 22)
__device__ __forceinline__ unsigned xb_ld(unsigned* p)              { return __hip_atomic_load(p, __ATOMIC_RELAXED, __HIP_MEMORY_SCOPE_AGENT); }
__device__ __forceinline__ unsigned xb_add(unsigned* p, unsigned v) { return __hip_atomic_fetch_add(p, v, __ATOMIC_RELAXED, __HIP_MEMORY_SCOPE_AGENT); }
__device__ __forceinline__ unsigned xb_xcc_id() { return (unsigned)__builtin_amdgcn_s_getreg((3 << 11) | 20) & 0xFu; }
#define XB_SPIN(cond, bar) do { unsigned _sp = 0; while (cond) { __builtin_amdgcn_s_sleep(1); \
    if ((++_sp & 255u) == 0u) { if (xb_ld(&(bar)[XB_TMO])) break; if (_sp > XB_SPIN_CAP) { atomicAdd(&(bar)[XB_TMO], 1u); break; } } } } while (0)
struct XcdBarrier { unsigned* bar; unsigned x; volatile LAS unsigned* st; };
__device__ __forceinline__ XcdBarrier xcd_barrier_post(unsigned* bar, volatile LAS unsigned* st) {
    XcdBarrier b; b.bar = bar; b.x = xb_xcc_id(); b.st = st;
    if (threadIdx.x == 0) (void)xb_add(&bar[XB_XCNT(b.x)], 1u);
    return b;
}
__device__ __forceinline__ void xcd_barrier_complete(unsigned* bar, unsigned x, unsigned& nloc, unsigned& nx) {
    const unsigned G = gridDim.x * gridDim.y * gridDim.z;
    unsigned sum, cnt, mine, sp = 0u;
    for (;;) {
        sum = 0u; cnt = 0u; mine = 0u;
#pragma unroll
        for (unsigned j = 0; j < 16; ++j) { const unsigned c = xb_ld(&bar[XB_XCNT(j)]); sum += c; cnt += (c > 0u) ? 1u : 0u; mine = (j == x) ? c : mine; }
        if (sum == G) break;
        __builtin_amdgcn_s_sleep(1);
        if ((++sp & 255u) == 0u) { if (xb_ld(&bar[XB_TMO])) break; if (sp > XB_SPIN_CAP) { atomicAdd(&bar[XB_TMO], 1u); break; } }
    }
    nloc = mine > 0u ? mine : 1u; nx = cnt > 0u ? cnt : 1u;
}
__device__ __forceinline__ void xcd_barrier(const XcdBarrier& b, int wv) {
    asm volatile("s_waitcnt vmcnt(0)" ::: "memory");
    __syncthreads();
    if (tid_opaque(wv) == 0) {
        unsigned* bar = b.bar;
        __builtin_amdgcn_s_waitcnt(0);
        unsigned nloc = b.st[0], nx = b.st[1];
        if (nloc == 0u) { xcd_barrier_complete(bar, b.x, nloc, nx); b.st[0] = nloc; b.st[1] = nx; }
        const unsigned old = xb_add(&bar[XB_XSUB(b.x)], 1u);
        const unsigned gen = old / nloc;
        if (old + 1u == (gen + 1u) * nloc) {
            __builtin_amdgcn_fence(__ATOMIC_RELEASE, "agent");
            asm volatile("s_waitcnt vmcnt(0)" ::: "memory");
            const unsigned og = xb_add(&bar[XB_TOP], 1u);
            const unsigned tg = og / nx;
            if (og + 1u == (tg + 1u) * nx) xb_add(&bar[XB_TOPGEN], 1u);
            else XB_SPIN(xb_ld(&bar[XB_TOPGEN]) == tg, bar);
            __builtin_amdgcn_fence(__ATOMIC_ACQUIRE, "agent");
            xb_add(&bar[XB_XGEN(b.x)], 1u);
            asm volatile("s_waitcnt vmcnt(0)" ::: "memory");
        } else {
            XB_SPIN(xb_ld(&bar[XB_XGEN(b.x)]) == gen, bar);
            __builtin_amdgcn_fence(__ATOMIC_ACQUIRE, "agent");
            asm volatile("s_waitcnt vmcnt(0)" ::: "memory");
        }
    }
    __syncthreads();
}

struct Args { const float* in[32]; float* out; unsigned char* ws; int ph_lo, ph_hi; };
enum { I_X = 0, I_C, I_CTX, I_CCTX, I_WADA, I_BADA, I_WIN, I_WGATE, I_BGATE, I_SGUG, I_SGUB, I_WSP, I_BSP, I_CONVW, I_LQ1, I_LK1, I_LQ2, I_LK2, I_SUBLN,
       I_WPA, I_WPB, I_WPC, I_WPD, I_WO, I_LN1G, I_LN1B, I_WROUTER, I_WEG, I_WEU, I_WED, I_LN2G, I_LN2B };

__device__ __forceinline__ const Args& fresh_args() { auto p = (const __attribute__((address_space(4))) Args*)__builtin_amdgcn_kernarg_segment_ptr(); asm volatile("" : "+s"(p)); return *(const Args*)p; }
struct Unit { const bf16* A; const bf16* B; const int* gidx; int lda, ldb, K, pm, pn, aux; };
__device__ __forceinline__ int perm32(int rho) { const int n = rho >> 4, i = rho & 15; return 8 * (i >> 2) + 4 * n + (i & 3); }

template <class Epi, class Sched>
__device__ __forceinline__ void gemm_phase(LAS unsigned char* lds, const Sched& S, const Epi& E, int wv) {
    const int tid = tid_opaque(wv), wid = __builtin_amdgcn_readfirstlane(tid >> 6), lane = tid & 63, wr = wid >> 2, wc = wid & 3, fr = lane & 15, fq = lane >> 4;
    Unit u;
    for (int i = 0; S.next(i, u); ++i) {
        f32x4 acc[2][2][4][2];
#pragma unroll
        for (int a = 0; a < 2; ++a)
#pragma unroll
            for (int b = 0; b < 2; ++b)
#pragma unroll
                for (int m = 0; m < 4; ++m)
#pragma unroll
                    for (int n = 0; n < 2; ++n) acc[a][b][m][n] = (f32x4){0.f, 0.f, 0.f, 0.f};
        unsigned ao[2][4], bo[2][2];
#pragma unroll
        for (int ai = 0; ai < 2; ++ai)
#pragma unroll
            for (int m = 0; m < 4; ++m) { const int r = ai * 128 + wr * 64 + m * 16 + fr; const unsigned gr = u.gidx ? (unsigned)u.gidx[r] : (unsigned)r; ao[ai][m] = gr * (unsigned)u.lda + fq * 8; }
#pragma unroll
        for (int bj = 0; bj < 2; ++bj)
#pragma unroll
            for (int n = 0; n < 2; ++n) { const int slot = n * 16 + fr; const int rr = Epi::PERM ? perm32(slot) : slot; bo[bj][n] = (unsigned)(bj * 128 + wc * 32 + rr) * (unsigned)u.ldb + fq * 8; }
        for (int k0 = 0; k0 < u.K; k0 += 64) {
#pragma unroll
            for (int ai = 0; ai < 2; ++ai) {
                bf16x8 At[4][2];
#pragma unroll
                for (int m = 0; m < 4; ++m)
#pragma unroll
                    for (int k = 0; k < 2; ++k) At[m][k] = *(const bf16x8*)(u.A + k0 + k * 32 + ao[ai][m]);
#pragma unroll
                for (int bj = 0; bj < 2; ++bj) {
                    bf16x8 Bf[2][2];
#pragma unroll
                    for (int n = 0; n < 2; ++n)
#pragma unroll
                        for (int k = 0; k < 2; ++k) Bf[n][k] = *(const bf16x8*)(u.B + k0 + k * 32 + bo[bj][n]);
#pragma unroll
                    for (int m = 0; m < 4; ++m)
#pragma unroll
                        for (int n = 0; n < 2; ++n)
#pragma unroll
                            for (int k = 0; k < 2; ++k) acc[ai][bj][m][n] = __builtin_amdgcn_mfma_f32_16x16x32_bf16(Bf[n][k], At[m][k], acc[ai][bj][m][n], 0, 0, 0);
                }
            }
        }
        E(acc, u, wr, wc, fr, fq);
    }
}

#define EPI_ROWS_BEGIN _Pragma("unroll") for (int ai = 0; ai < 2; ++ai) _Pragma("unroll") for (int m = 0; m < 4; ++m) { const int rl = ai * 128 + wr * 64 + m * 16 + fr;
#define EPI_ROWS_END }
__device__ __forceinline__ u32x4 pack8(const f32x4 a, const f32x4 b) { u32x4 w; w.x = cvt_pk_bf16(a[0], a[1]); w.y = cvt_pk_bf16(a[2], a[3]); w.z = cvt_pk_bf16(b[0], b[1]); w.w = cvt_pk_bf16(b[2], b[3]); return w; }
__device__ __forceinline__ void unpack8(const u32x4 w, float (&f)[8]) { f[0] = bflo(w.x); f[1] = bfhi(w.x); f[2] = bflo(w.y); f[3] = bfhi(w.y); f[4] = bflo(w.z); f[5] = bfhi(w.z); f[6] = bflo(w.w); f[7] = bfhi(w.w); }

struct EpiIn {
    static constexpr bool PERM = true;
    bf16* Z; bf16* ZT; const float* ropec; const float* ropes;
    __device__ __forceinline__ void operator()(const f32x4 (&acc)[2][2][4][2], const Unit& u, int wr, int wc, int fr, int fq) const {
        const int pn = u.pn; const bool lat = u.pm < 64;
        EPI_ROWS_BEGIN
            const int row = u.pm * 256 + rl;
#pragma unroll
            for (int bj = 0; bj < 2; ++bj) {
                const int col0 = pn * 256 + bj * 128 + wc * 32 + 8 * fq;
                f32x4 v0 = acc[ai][bj][m][0], v1 = acc[ai][bj][m][1];
                if (pn < 2) {
#pragma unroll
                    for (int j = 0; j < 4; ++j) { v0[j] = gelu_tanh(v0[j]); v1[j] = gelu_tanh(v1[j]); }
                } else if (pn >= 5 && pn <= 8 && lat) {
                    const int t = row & 2047, p0 = (col0 & 63) >> 1;
                    const f32x4 cs = *(const f32x4*)(ropec + t * 32 + p0), sn = *(const f32x4*)(ropes + t * 32 + p0);
                    const f32x4 a = v0, b = v1;
                    v0[0] = a[0] * cs[0] - a[1] * sn[0]; v0[1] = a[0] * sn[0] + a[1] * cs[0];
                    v0[2] = a[2] * cs[1] - a[3] * sn[1]; v0[3] = a[2] * sn[1] + a[3] * cs[1];
                    v1[0] = b[0] * cs[2] - b[1] * sn[2]; v1[1] = b[0] * sn[2] + b[1] * cs[2];
                    v1[2] = b[2] * cs[3] - b[3] * sn[3]; v1[3] = b[2] * sn[3] + b[3] * cs[3];
                }
                if (pn < 11) {
                    *(u32x4*)(Z + (size_t)row * ZC + col0) = pack8(v0, v1);
                } else {
                    const int cc = col0 - pn * 256;
#pragma unroll
                    for (int j = 0; j < 8; ++j) {
                        const float val = j < 4 ? v0[j & 3] : v1[j & 3];
                        size_t o;
                        if (lat) { const int b = row >> 11, n = row & 2047; o = ((size_t)(b * 256 + cc + j)) * 4096 + (pn == 12 ? 2048 : 0) + n; }
                        else { const int rc = row - RL, b = rc >> 8, n = rc & 255; o = (size_t)8 * 256 * 4096 + ((size_t)(b * 256 + cc + j)) * 512 + (pn == 12 ? 256 : 0) + n; }
                        ZT[o] = f2bf(val);
                    }
                }
            }
        EPI_ROWS_END
    }
};
struct EpiStoreBf16 {
    static constexpr bool PERM = true;
    bf16* O; int ldc;
    __device__ __forceinline__ void operator()(const f32x4 (&acc)[2][2][4][2], const Unit& u, int wr, int wc, int fr, int fq) const {
        EPI_ROWS_BEGIN
#pragma unroll
            for (int bj = 0; bj < 2; ++bj) { const int col0 = u.pn * 256 + bj * 128 + wc * 32 + 8 * fq;
                *(u32x4*)(O + (size_t)(u.aux + rl) * ldc + col0) = pack8(acc[ai][bj][m][0], acc[ai][bj][m][1]); }
        EPI_ROWS_END
    }
};
struct EpiGate {
    static constexpr bool PERM = true;
    const bf16* P; bf16* M2; const float* bgate;
    __device__ __forceinline__ void operator()(const f32x4 (&acc)[2][2][4][2], const Unit& u, int wr, int wc, int fr, int fq) const {
        const int p = u.pn >> 3, cb = (u.pn & 7) * 128 + wc * 32 + 8 * fq;
        float b0[8], b1[8];
        { const f32x4 x0 = *(const f32x4*)(bgate + (2 * p) * 1024 + cb), x1 = *(const f32x4*)(bgate + (2 * p) * 1024 + cb + 4), y0 = *(const f32x4*)(bgate + (2 * p + 1) * 1024 + cb), y1 = *(const f32x4*)(bgate + (2 * p + 1) * 1024 + cb + 4);
#pragma unroll
          for (int j = 0; j < 4; ++j) { b0[j] = x0[j]; b0[4 + j] = x1[j]; b1[j] = y0[j]; b1[4 + j] = y1[j]; } }
        EPI_ROWS_BEGIN
            const size_t row = (size_t)u.pm * 256 + rl;
            float p0[8], p1[8];
            unpack8(*(const u32x4*)(P + row * PC + (2 * p) * 1024 + cb), p0);
            unpack8(*(const u32x4*)(P + row * PC + (2 * p + 1) * 1024 + cb), p1);
            f32x4 o0, o1;
#pragma unroll
            for (int j = 0; j < 4; ++j) {
                o0[j] = sigmoid_f(acc[ai][0][m][0][j] + b0[j]) * p0[j] + sigmoid_f(acc[ai][1][m][0][j] + b1[j]) * p1[j];
                o1[j] = sigmoid_f(acc[ai][0][m][1][j] + b0[4 + j]) * p0[4 + j] + sigmoid_f(acc[ai][1][m][1][j] + b1[4 + j]) * p1[4 + j];
            }
            *(u32x4*)(M2 + row * M2C + p * 1024 + cb) = pack8(o0, o1);
        EPI_ROWS_END
    }
};
struct EpiF32 {
    static constexpr bool PERM = false;
    float* C; int ldc;
    __device__ __forceinline__ void operator()(const f32x4 (&acc)[2][2][4][2], const Unit& u, int wr, int wc, int fr, int fq) const {
        EPI_ROWS_BEGIN
            float* rowp = C + ((size_t)u.pm * 256 + rl) * ldc + u.pn * 256 + wc * 32 + 4 * fq;
#pragma unroll
            for (int bj = 0; bj < 2; ++bj)
#pragma unroll
                for (int n = 0; n < 2; ++n) *(f32x4*)(rowp + bj * 128 + n * 16) = acc[ai][bj][m][n];
        EPI_ROWS_END
    }
};
struct EpiSwiglu {
    static constexpr bool PERM = true;
    bf16* HID;
    __device__ __forceinline__ void operator()(const f32x4 (&acc)[2][2][4][2], const Unit& u, int wr, int wc, int fr, int fq) const {
        EPI_ROWS_BEGIN
            f32x4 o0, o1;
#pragma unroll
            for (int j = 0; j < 4; ++j) { const float g0 = acc[ai][0][m][0][j], g1 = acc[ai][0][m][1][j];
                o0[j] = g0 * sigmoid_f(g0) * acc[ai][1][m][0][j]; o1[j] = g1 * sigmoid_f(g1) * acc[ai][1][m][1][j]; }
            *(u32x4*)(HID + ((size_t)u.pm * 256 + rl) * 1024 + u.pn * 128 + wc * 32 + 8 * fq) = pack8(o0, o1);
        EPI_ROWS_END
    }
};
struct EpiDown {
    static constexpr bool PERM = true;
    bf16* YE; const float* GV;
    __device__ __forceinline__ void operator()(const f32x4 (&acc)[2][2][4][2], const Unit& u, int wr, int wc, int fr, int fq) const {
        EPI_ROWS_BEGIN
            const size_t row = (size_t)u.pm * 256 + rl; const float g = GV[row];
#pragma unroll
            for (int bj = 0; bj < 2; ++bj) *(u32x4*)(YE + row * 1024 + u.pn * 256 + bj * 128 + wc * 32 + 8 * fq) = pack8(acc[ai][bj][m][0] * g, acc[ai][bj][m][1] * g);
        EPI_ROWS_END
    }
};

struct SchedIn {
    const bf16* HL; const bf16* W; int G, c; bool last;
    __device__ __forceinline__ bool next(int i, Unit& u) const {
        const int idx = i * G + c; int pm, pn;
        if (!last) { if (idx >= 72 * 13) return false; pm = idx / 13; pn = idx % 13; }
        else { if (idx >= 64 * 13 + 32) return false; if (idx < 64 * 13) { pm = idx / 13; pn = idx % 13; } else { const int q = idx - 64 * 13; pm = 64 + (q >> 2); pn = 7 + (q & 3); } }
        u.A = HL + (size_t)pm * 256 * D; u.B = W + (size_t)pn * 256 * D; u.gidx = nullptr; u.lda = D; u.ldb = D; u.K = D; u.pm = pm; u.pn = pn; u.aux = 0; return true;
    }
};
struct SchedFourier {
    const bf16* FL; const bf16* FC; const bf16* ZT; int G, c; bool last;
    __device__ __forceinline__ bool next(int i, Unit& u) const {
        const int idx = i * G + c; if (idx >= (last ? 64 : 72)) return false;
        u.gidx = nullptr; u.pn = 4;
        if (idx < 64) { const int b = idx >> 3, pm = idx & 7; u.A = FL + (size_t)pm * 256 * 4096; u.B = ZT + (size_t)b * 256 * 4096; u.lda = 4096; u.ldb = 4096; u.K = 4096; u.pm = idx; u.aux = b * 2048 + pm * 256; }
        else { const int b = idx - 64; u.A = FC; u.B = ZT + (size_t)8 * 256 * 4096 + (size_t)b * 256 * 512; u.lda = 512; u.ldb = 512; u.K = 512; u.pm = idx; u.aux = RL + b * 256; }
        return true;
    }
};
struct SchedP {
    const bf16* Y; const bf16* W; int G, c, npan;
    __device__ __forceinline__ bool next(int i, Unit& u) const {
        const int idx = i * G + c; if (idx >= npan * 16) return false;
        const int pm = idx >> 4, q = idx & 15, br = q >> 2, pnl = q & 3;
        const int coff = br == 0 ? 0 : (br == 1 ? 256 : (br == 2 ? 512 : 1024));
        u.A = Y + (size_t)pm * 256 * YC + coff; u.B = W + ((size_t)br * 1024 + pnl * 256) * 512; u.gidx = nullptr; u.lda = YC; u.ldb = 512; u.K = br == 2 ? 512 : 256; u.pm = pm; u.pn = q; u.aux = pm * 256; return true;
    }
};
struct SchedGate {
    const bf16* HL; const bf16* W; int G, c, npan;
    __device__ __forceinline__ bool next(int i, Unit& u) const {
        const int idx = i * G + c; if (idx >= npan * 16) return false;
        const int pm = idx >> 4, tn = idx & 15;
        u.A = HL + (size_t)pm * 256 * D; u.B = W + (size_t)tn * 256 * D; u.gidx = nullptr; u.lda = D; u.ldb = D; u.K = D; u.pm = pm; u.pn = tn; u.aux = 0; return true;
    }
};
struct SchedWo {
    const bf16* M2; const bf16* W; int G, c, npan;
    __device__ __forceinline__ bool next(int i, Unit& u) const {
        const int idx = i * G + c; if (idx >= npan * 4) return false;
        const int pm = idx >> 2, pn = idx & 3;
        u.A = M2 + (size_t)pm * 256 * M2C; u.B = W + (size_t)pn * 256 * M2C; u.gidx = nullptr; u.lda = M2C; u.ldb = M2C; u.K = M2C; u.pm = pm; u.pn = pn; u.aux = 0; return true;
    }
};
struct SchedE1 {
    const bf16* HL; const bf16* W; const int* IDX; int G, c, npanel;
    __device__ __forceinline__ bool next(int i, Unit& u) const {
        const int idx = i * G + c; if (idx >= npanel * 8) return false;
        const int panel = idx >> 3, tn = idx & 7, e = panel < 128 ? (panel >> 3) : (panel - 128);
        u.A = HL; u.B = W + ((size_t)e * 2048 + tn * 256) * D; u.gidx = IDX + panel * 256; u.lda = D; u.ldb = D; u.K = D; u.pm = panel; u.pn = tn; u.aux = e; return true;
    }
};
struct SchedE2 {
    const bf16* HID; const bf16* W; int G, c, npanel;
    __device__ __forceinline__ bool next(int i, Unit& u) const {
        const int idx = i * G + c; if (idx >= npanel * 4) return false;
        const int panel = idx >> 2, pn = idx & 3, e = panel < 128 ? (panel >> 3) : (panel - 128);
        u.A = HID + (size_t)panel * 256 * 1024; u.B = W + ((size_t)e * 1024 + pn * 256) * 1024; u.gidx = nullptr; u.lda = 1024; u.ldb = 1024; u.K = 1024; u.pm = panel; u.pn = pn; u.aux = e; return true;
    }
};

constexpr int AT_SHM_V = 64 * 128 * 2, AT_SHM_K = 64 * 64 * 2;
#define KSWZ64(row, colB) ((row) * 128 + ((colB) ^ ((((row) >> 1) & 7) << 4)))
#define SBAR() __builtin_amdgcn_sched_barrier(0)
__device__ __forceinline__ int crow(int r, int hi) { return (r & 3) + 8 * (r >> 2) + 4 * hi; }
constexpr float AT_SCALE = 0.125f, AT_THR = 8.f;
__device__ __forceinline__ void partialSM(f32x16& p0, f32x16& p1, float& m_reg, float& mn, float& alpha) {
    constexpr float C = AT_SCALE * 1.4426950408889634f;
    float pmax = p0[0];
#pragma unroll
    for (int r = 1; r < 16; ++r) pmax = fmaxf(pmax, p0[r]);
#pragma unroll
    for (int r = 0; r < 16; ++r) pmax = fmaxf(pmax, p1[r]);
    { auto rr = __builtin_amdgcn_permlane32_swap(__float_as_uint(pmax), __float_as_uint(pmax), false, false);
      pmax = fmaxf(__uint_as_float(rr[0]), __uint_as_float(rr[1])); }
    if (__builtin_expect(__all(pmax - m_reg <= AT_THR / AT_SCALE), 1)) { mn = m_reg; alpha = 1.f; }
    else { mn = fmaxf(m_reg, pmax); alpha = __builtin_amdgcn_exp2f((m_reg - mn) * C); m_reg = mn; }
    const float mnC = -mn * C;
#pragma unroll
    for (int r = 0; r < 16; ++r) p0[r] = fmaf(p0[r], C, mnC);
#pragma unroll
    for (int r = 0; r < 16; ++r) p1[r] = fmaf(p1[r], C, mnC);
#pragma unroll
    for (int r = 0; r < 16; ++r) p0[r] = __builtin_amdgcn_exp2f(p0[r]);
}
__device__ __forceinline__ void finishSM(f32x16& p0, f32x16& p1, float alpha, float& l_reg, bf16x8& pa0, bf16x8& pa1, bf16x8& pa2, bf16x8& pa3) {
#pragma unroll
    for (int r = 0; r < 16; ++r) p1[r] = __builtin_amdgcn_exp2f(p1[r]);
    float ps = 0;
#pragma unroll
    for (int r = 0; r < 16; ++r) ps += p0[r];
#pragma unroll
    for (int r = 0; r < 16; ++r) ps += p1[r];
    { auto rr = __builtin_amdgcn_permlane32_swap(__float_as_uint(ps), __float_as_uint(ps), false, false);
      ps = __uint_as_float(rr[0]) + __uint_as_float(rr[1]); }
    l_reg = l_reg * alpha + ps;
#define PK4(P, BASE, OUT) do { unsigned a0 = cvt_pk_bf16(P[BASE + 0], P[BASE + 1]), a1 = cvt_pk_bf16(P[BASE + 2], P[BASE + 3]);   \
    unsigned b0 = cvt_pk_bf16(P[BASE + 4], P[BASE + 5]), b1 = cvt_pk_bf16(P[BASE + 6], P[BASE + 7]);                              \
    auto r0 = __builtin_amdgcn_permlane32_swap(a0, b0, false, false); auto r1 = __builtin_amdgcn_permlane32_swap(a1, b1, false, false); \
    u32x4 w = {r0[0], r1[0], r0[1], r1[1]}; OUT = *reinterpret_cast<bf16x8*>(&w); } while (0)
    PK4(p0, 0, pa0); PK4(p0, 8, pa1); PK4(p1, 0, pa2); PK4(p1, 8, pa3);
#undef PK4
}
__device__ __forceinline__ void qkt(f32x16& p0, f32x16& p1, const LAS char* Ks, const bf16x8 (&qr)[4], int r32, int hi) {
    p0 = f32x16{}; p1 = f32x16{};
#pragma unroll
    for (int d0 = 0; d0 < 4; ++d0) { const int cb = (d0 * 16 + hi * 8) * 2;
        const bf16x8 b0 = *(const LAS bf16x8*)(Ks + KSWZ64(r32, cb));
        const bf16x8 b1 = *(const LAS bf16x8*)(Ks + KSWZ64(32 + r32, cb));
        p0 = __builtin_amdgcn_mfma_f32_32x32x16_bf16(b0, qr[d0], p0, 0, 0, 0);
        p1 = __builtin_amdgcn_mfma_f32_32x32x16_bf16(b1, qr[d0], p1, 0, 0, 0); }
}
__device__ __forceinline__ int v_st(int k, int c) { const int kk = (k & ~0xC) | ((k & 4) << 1) | ((k & 8) >> 1); return ((kk >> 3) * 4 + (c >> 5)) * 512 + ((kk & 7) * 32 + (c & 31)) * 2; }
__device__ __forceinline__ int v_rd_base(int lane) { return ((lane & 3) << 3) | (((lane >> 2) & 3) << 6) | (((lane >> 4) & 1) << 5) | (((lane >> 5) & 1) << 8); }
constexpr int v_rd_off(int d0, int ks, int half) { return d0 * 512 + ks * 4096 + half * 2048; }
template <int OFF> __device__ __forceinline__ s16x4 tr_read(int vb) {
    s16x4 r; asm volatile("ds_read_b64_tr_b16 %0, %1 offset:%2" : "=&v"(r) : "v"(vb), "i"(OFF) : "memory"); return r;
}
template <int D0> __device__ __forceinline__ void pv_one(f32x16& od, int vb, bf16x8 pa0, bf16x8 pa1, bf16x8 pa2, bf16x8 pa3) {
    const s16x4 l0 = tr_read<v_rd_off(D0, 0, 0)>(vb), h0 = tr_read<v_rd_off(D0, 0, 1)>(vb), l1 = tr_read<v_rd_off(D0, 1, 0)>(vb), h1 = tr_read<v_rd_off(D0, 1, 1)>(vb);
    const s16x4 l2 = tr_read<v_rd_off(D0, 2, 0)>(vb), h2 = tr_read<v_rd_off(D0, 2, 1)>(vb), l3 = tr_read<v_rd_off(D0, 3, 0)>(vb), h3 = tr_read<v_rd_off(D0, 3, 1)>(vb);
    asm volatile("s_waitcnt lgkmcnt(0)" ::: "memory"); SBAR();
#define PK(L, H) (bf16x8){L[0], L[1], L[2], L[3], H[0], H[1], H[2], H[3]}
    od = __builtin_amdgcn_mfma_f32_32x32x16_bf16(pa0, PK(l0, h0), od, 0, 0, 0);
    od = __builtin_amdgcn_mfma_f32_32x32x16_bf16(pa1, PK(l1, h1), od, 0, 0, 0);
    od = __builtin_amdgcn_mfma_f32_32x32x16_bf16(pa2, PK(l2, h2), od, 0, 0, 0);
    od = __builtin_amdgcn_mfma_f32_32x32x16_bf16(pa3, PK(l3, h3), od, 0, 0, 0);
#undef PK
}
__device__ __forceinline__ void pv_d0(f32x16 (&o)[4], int vb, bf16x8 pa0, bf16x8 pa1, bf16x8 pa2, bf16x8 pa3) {
    pv_one<0>(o[0], vb, pa0, pa1, pa2, pa3); pv_one<1>(o[1], vb, pa0, pa1, pa2, pa3); pv_one<2>(o[2], vb, pa0, pa1, pa2, pa3); pv_one<3>(o[3], vb, pa0, pa1, pa2, pa3);
}
template <int pass> __device__ __forceinline__ void attn_pass(const bf16* Z, float* O1, int qrow0, int crow0, int lrow0, int ntc, int nt, int h, LAS char* lds, int wv) {
    const int tid = tid_opaque(wv), wid = tid >> 6, lane = tid & 63, r32 = lane & 31, hi = lane >> 5;
    LAS char* V_lds = lds; LAS char* K_lds = lds + 2 * AT_SHM_V;
    LAS float* ws = (LAS float*)(lds + 2 * AT_SHM_V + 2 * AT_SHM_K) + wid * 64; LAS float* li_l = ws; LAS float* al_l = ws + 32;
    const int sr = tid >> 4, sc = (tid & 15) * 8, vst0 = v_st(sr, sc), vst1 = v_st(32 + sr, sc);
    const int srk = tid >> 3, sck = (tid & 7) * 8;
    const int vgo0 = sr * ZC + sc, kgo0 = srk * ZC + sck, kst0 = KSWZ64(srk, sck * 2);
    const int vb0 = (int)(uintptr_t)V_lds + v_rd_base(lane);
    {
        float m_reg = -1e30f, l_reg = 0; f32x16 o[4] = {}; bf16x8 qr[4];
        const bf16* Qw = Z + (size_t)(qrow0 + wid * 32 + r32) * ZC + 1280 + h * 128 + pass * 64 + hi * 8;
#pragma unroll
        for (int d0 = 0; d0 < 4; ++d0) qr[d0] = *(const bf16x8*)(Qw + d0 * 16);
        const bf16* Kc = Z + 1792 + h * 128 + pass * 64; const bf16* Vc = Z + 2304 + h * 128;
        struct { bf16x8 vs0, vs1, ks0; } sr_[2];
#define KROW(t) ((t) < ntc ? crow0 + (t) * 64 : lrow0 + ((t) - ntc) * 64)
#define SLOAD(i, t) do { const size_t _r = (size_t)__builtin_amdgcn_readfirstlane(KROW(t)) * ZC; const bf16* _v = Vc + _r; const bf16* _k = Kc + _r; \
    sr_[i].vs0 = *(const bf16x8*)(_v + vgo0); sr_[i].vs1 = *(const bf16x8*)(_v + vgo0 + 32 * ZC); sr_[i].ks0 = *(const bf16x8*)(_k + kgo0); } while (0)
#define SWRITE(b, i) do { *(LAS bf16x8*)(V_lds + (b) * AT_SHM_V + vst0) = sr_[i].vs0; *(LAS bf16x8*)(V_lds + (b) * AT_SHM_V + vst1) = sr_[i].vs1; \
    *(LAS bf16x8*)(K_lds + (b) * AT_SHM_K + kst0) = sr_[i].ks0; } while (0)
#define SWAIT() asm volatile("s_waitcnt vmcnt(3)" ::: "memory")
#define RESC(a) do { if (__any((a) < 1.f)) { if (hi == 0) al_l[r32] = (a); asm volatile("s_waitcnt lgkmcnt(0)" ::: "memory"); \
    _Pragma("unroll") for (int d = 0; d < 4; ++d) _Pragma("unroll") for (int r = 0; r < 16; ++r) o[d][r] *= al_l[crow(r, hi)]; } } while (0)
        f32x16 pA0, pA1, pB0, pB1; float mnA, mnB, alA, alB; bf16x8 pa0, pa1, pa2, pa3;
        __syncthreads();
        SLOAD(0, 0); asm volatile("s_waitcnt vmcnt(0)" ::: "memory"); SWRITE(0, 0); __syncthreads();
        qkt(pA0, pA1, K_lds, qr, r32, hi); partialSM(pA0, pA1, m_reg, mnA, alA);
        SLOAD(1, 1); if (2 < nt) SLOAD(0, 2);
        SWAIT(); SWRITE(1, 1); __syncthreads();
        for (int j = 1; j + 1 < nt; j += 2) {
            SBAR(); qkt(pB0, pB1, K_lds + AT_SHM_K, qr, r32, hi);
            finishSM(pA0, pA1, alA, l_reg, pa0, pa1, pa2, pa3); SBAR();
            SLOAD(1, j + 2); SBAR();
            pv_d0(o, vb0, pa0, pa1, pa2, pa3); partialSM(pB0, pB1, m_reg, mnB, alB);
            __syncthreads(); SWAIT(); SWRITE(0, 0);
            RESC(alB); __syncthreads();
            SBAR(); qkt(pA0, pA1, K_lds, qr, r32, hi);
            finishSM(pB0, pB1, alB, l_reg, pa0, pa1, pa2, pa3); SBAR();
            if (j + 3 < nt) SLOAD(0, j + 3); SBAR();
            pv_d0(o, vb0 + AT_SHM_V, pa0, pa1, pa2, pa3); partialSM(pA0, pA1, m_reg, mnA, alA);
            __syncthreads(); SWAIT(); SWRITE(1, 1);
            RESC(alA); __syncthreads();
        }
        SBAR(); qkt(pB0, pB1, K_lds + AT_SHM_K, qr, r32, hi);
        finishSM(pA0, pA1, alA, l_reg, pa0, pa1, pa2, pa3); SBAR();
        pv_d0(o, vb0, pa0, pa1, pa2, pa3); partialSM(pB0, pB1, m_reg, mnB, alB);
        __syncthreads(); RESC(alB);
        finishSM(pB0, pB1, alB, l_reg, pa0, pa1, pa2, pa3); SBAR();
        pv_d0(o, vb0 + AT_SHM_V, pa0, pa1, pa2, pa3);
        if (hi == 0) li_l[r32] = l_reg; asm volatile("s_waitcnt lgkmcnt(0)" ::: "memory");
#pragma unroll
        for (int r = 0; r < 16; ++r) { const float rl_ = __builtin_amdgcn_rcpf(li_l[crow(r, hi)]);
#pragma unroll
            for (int d0 = 0; d0 < 4; ++d0) o[d0][r] *= rl_; }
        const int orow0 = qrow0 + wid * 32;
        float* Op = O1 + (size_t)pass * ((size_t)R * 512);
#pragma unroll
        for (int r = 0; r < 16; ++r)
#pragma unroll
            for (int d0 = 0; d0 < 4; ++d0) Op[(size_t)(orow0 + crow(r, hi)) * 512 + h * 128 + d0 * 32 + r32] = o[d0][r];
    }
#undef KROW
#undef SLOAD
#undef SWRITE
#undef SWAIT
#undef RESC
}
__device__ __forceinline__ void attn_combine(float* O1, bf16* Y, int qrow0, int h, float lam, float osc, const float* subg, int wv) {
    const int tid = tid_opaque(wv), wid = tid >> 6, lane = tid & 63;
    asm volatile("s_waitcnt vmcnt(0)" ::: "memory");
    {
        const float* O2 = O1 + (size_t)R * 512; const int orow0 = qrow0 + wid * 32;
        const float g0 = subg[lane] * osc, g1 = subg[64 + lane] * osc;
        for (int rr = 0; rr < 32; ++rr) {
            const size_t o_ = (size_t)(orow0 + rr) * 512 + h * 128 + lane;
            const float a0 = __hip_atomic_load(O1 + o_, __ATOMIC_RELAXED, __HIP_MEMORY_SCOPE_AGENT), a1 = __hip_atomic_load(O1 + o_ + 64, __ATOMIC_RELAXED, __HIP_MEMORY_SCOPE_AGENT);
            const float b0 = __hip_atomic_load(O2 + o_, __ATOMIC_RELAXED, __HIP_MEMORY_SCOPE_AGENT), b1 = __hip_atomic_load(O2 + o_ + 64, __ATOMIC_RELAXED, __HIP_MEMORY_SCOPE_AGENT);
            const float v0 = a0 - lam * b0, v1 = a1 - lam * b1;
            const float ss = wave_sum(v0 * v0 + v1 * v1);
            const float rs = 1.0f / sqrtf(ss * (1.f / 128.f) + RMS_EPS);
            bf16* yr = Y + (size_t)(orow0 + rr) * YC + 512 + h * 128 + lane;
            yr[0] = f2bf(v0 * rs * g0); yr[64] = f2bf(v1 * rs * g1);
        }
    }
}

__device__ __forceinline__ void row_stats(const f32x4 (&v)[4], float& mean, float& rstd) {
    float s = 0.f;
#pragma unroll
    for (int j = 0; j < 4; ++j) s += (v[j][0] + v[j][1]) + (v[j][2] + v[j][3]);
    mean = wave_sum(s) * (1.f / D); float q = 0.f;
#pragma unroll
    for (int j = 0; j < 4; ++j) { const f32x4 d = v[j] - mean; q += (d[0] * d[0] + d[1] * d[1]) + (d[2] * d[2] + d[3] * d[3]); }
    rstd = 1.0f / sqrtf(wave_sum(q) * (1.f / D) + LN_EPS);
}
__device__ __forceinline__ void store_h(bf16* HLrow, const f32x4 (&v)[4], float mean, float rstd, const float* shift, const float* scale, int lane) {
#pragma unroll
    for (int j = 0; j < 4; ++j) { const int c = 4 * lane + 256 * j; const f32x4 sh = *(const f32x4*)(shift + c), sc = *(const f32x4*)(scale + c);
        const f32x4 h = (v[j] - mean) * rstd * (sc + 1.f) + sh; u32x2 w; w.x = cvt_pk_bf16(h[0], h[1]); w.y = cvt_pk_bf16(h[2], h[3]); *(u32x2*)(HLrow + c) = w; }
}
template <int MODE>
__device__ __forceinline__ void ph_ln(const Args& a, int l, bool last, LAS unsigned char* lds, int G, int wg, int wv) {
    const int tid = tid_opaque(wv), lane = tid & 63, wave = tid >> 6, gw = wg * 8 + wave, NGW = G * 8;
    float* X = (float*)(a.ws + WS_X); bf16* HL = (bf16*)(a.ws + WS_HL); const float* ADA = (const float*)(a.ws + WS_ADA);
    LAS float* wr_l = (LAS float*)lds;
    if (MODE == 1) {
        const float* wrt = a.in[I_WROUTER] + (size_t)l * D * NE;
        for (int i = tid; i < D * NE; i += 512) { const int k = i >> 4, e = i & 15; wr_l[e * D + k] = wrt[i]; }
        __syncthreads();
    }
    const int nrows = (MODE != 0 && last) ? RL : R;
    for (int row = gw; row < nrows; row += NGW) {
        const int bc = row < RL ? (row >> 11) : 8;
        f32x4 v[4]; float mean, rstd;
        if (MODE == 0) {
            const float* src = row < RL ? a.in[I_X] + (size_t)row * D : a.in[I_CTX] + (size_t)(row - RL) * D;
#pragma unroll
            for (int j = 0; j < 4; ++j) { v[j] = *(const f32x4*)(src + 4 * lane + 256 * j); *(f32x4*)(X + (size_t)row * D + 4 * lane + 256 * j) = v[j]; }
            row_stats(v, mean, rstd);
            const float* ad = ADA + (size_t)(0 * 9 + bc) * 6144;
            store_h(HL + (size_t)row * D, v, mean, rstd, ad, ad + 1024, lane);
        } else {
            const float* ad = ADA + (size_t)(l * 9 + bc) * 6144;
            const float* gate = ad + (MODE == 1 ? 2048 : 5120);
            if (MODE == 1) {
                const float* T = (const float*)(a.ws + WS_R2) + (size_t)row * D;
#pragma unroll
                for (int j = 0; j < 4; ++j) { const int c = 4 * lane + 256 * j; v[j] = *(const f32x4*)(X + (size_t)row * D + c) * DN_ALPHA + *(const f32x4*)(gate + c) * *(const f32x4*)(T + c); }
            } else {
                const int* INV = (const int*)(a.ws + WS_INV) + (size_t)row * 16; const bf16* YE = (const bf16*)(a.ws + WS_R2 + 72 * MiB);
                const int myinv = lane < 16 ? INV[lane] : -1;
                f32x4 mo[4];
#pragma unroll
                for (int j = 0; j < 4; ++j) mo[j] = (f32x4){0.f, 0.f, 0.f, 0.f};
                for (int e = 0; e < 16; ++e) { const int r = __shfl(myinv, e);
                    if (r >= 0) {
#pragma unroll
                        for (int j = 0; j < 4; ++j) { const u32x2 w = *(const u32x2*)(YE + (size_t)r * 1024 + 4 * lane + 256 * j); mo[j][0] += bflo(w.x); mo[j][1] += bfhi(w.x); mo[j][2] += bflo(w.y); mo[j][3] += bfhi(w.y); }
                    } }
#pragma unroll
                for (int j = 0; j < 4; ++j) { const int c = 4 * lane + 256 * j; v[j] = *(const f32x4*)(X + (size_t)row * D + c) * DN_ALPHA + *(const f32x4*)(gate + c) * mo[j]; }
            }
            row_stats(v, mean, rstd);
            const float* g = a.in[MODE == 1 ? I_LN1G : I_LN2G] + l * D; const float* b = a.in[MODE == 1 ? I_LN1B : I_LN2B] + l * D;
#pragma unroll
            for (int j = 0; j < 4; ++j) { const int c = 4 * lane + 256 * j; v[j] = (v[j] - mean) * rstd * *(const f32x4*)(g + c) + *(const f32x4*)(b + c); *(f32x4*)(X + (size_t)row * D + c) = v[j];
                if (MODE == 2 && last) *(f32x4*)(a.out + (size_t)row * D + c) = v[j]; }
            if (MODE == 1 || !last) {
                row_stats(v, mean, rstd);
                const float* ad2 = MODE == 1 ? ad + 3072 : ADA + (size_t)((l + 1) * 9 + bc) * 6144;
                store_h(HL + (size_t)row * D, v, mean, rstd, ad2, ad2 + 1024, lane);
                if (MODE == 1) {
                    float lg[16];
#pragma unroll
                    for (int e = 0; e < 16; ++e) lg[e] = 0.f;
#pragma unroll
                    for (int j = 0; j < 4; ++j) { const int c = 4 * lane + 256 * j; const f32x4 sh = *(const f32x4*)(ad2 + c), sc = *(const f32x4*)(ad2 + 1024 + c);
                        const f32x4 h = (v[j] - mean) * rstd * (sc + 1.f) + sh;
#pragma unroll
                        for (int e = 0; e < 16; ++e) { const f32x4 w = *(const LAS f32x4*)(wr_l + e * D + c); lg[e] += (h[0] * w[0] + h[1] * w[1]) + (h[2] * w[2] + h[3] * w[3]); } }
                    float mx = -1e30f;
#pragma unroll
                    for (int e = 0; e < 16; ++e) { lg[e] = wave_sum(lg[e]); mx = fmaxf(mx, lg[e]); }
                    float se = 0.f;
#pragma unroll
                    for (int e = 0; e < 16; ++e) { lg[e] = expf(lg[e] - mx); se += lg[e]; }
                    float mine = 0.f;
#pragma unroll
                    for (int e = 0; e < 16; ++e) mine = (lane == e) ? lg[e] : mine;
                    float* AFF = (float*)(a.ws + WS_AFF);
                    if (lane < 16) {
                        if (row < RL) AFF[((size_t)(row >> 11) * 16 + lane) * 2048 + (row & 2047)] = mine / se;
                        else { const int rc = row - RL; AFF[(size_t)8 * 16 * 2048 + ((size_t)(rc >> 8) * 16 + lane) * 256 + (rc & 255)] = mine / se; }
                    }
                }
            }
        }
    }
}

__device__ __forceinline__ int block_excl_scan(int v, LAS int* wtot, int lane, int wave, int& total) {
    int inc = v;
#pragma unroll
    for (int o = 1; o < 64; o <<= 1) { const int t = __shfl_up(inc, o); if (lane >= o) inc += t; }
    if (lane == 63) wtot[wave] = inc;
    __syncthreads();
    int base = 0, tot = 0;
#pragma unroll
    for (int w = 0; w < 8; ++w) { const int x = wtot[w]; tot += x; if (w < wave) base += x; }
    __syncthreads();
    total = tot; return base + inc - v;
}
__device__ __forceinline__ void ph_topk(const Args& a, bool last, LAS unsigned char* lds, int G, int wg, int wv) {
    const int tid = tid_opaque(wv), lane = tid & 63, wave = tid >> 6;
    LAS unsigned* cnt = (LAS unsigned*)lds; LAS int* wtot = (LAS int*)(lds + 256);
    const float* AFF = (const float*)(a.ws + WS_AFF); int* IDX = (int*)(a.ws + WS_IDX); float* GV = (float*)(a.ws + WS_GV); int* INV = (int*)(a.ws + WS_INV);
    const int nunits = last ? 128 : 256;
    for (int u = wg; u < nunits; u += G) {
        const bool lat = u < 128; const int b = lat ? (u >> 4) : ((u - 128) >> 4), e = u & 15;
        const int n = lat ? 2048 : 256, cap = lat ? CAPL : CAPC;
        const float* af = lat ? AFF + ((size_t)b * 16 + e) * 2048 : AFF + (size_t)8 * 16 * 2048 + ((size_t)b * 16 + e) * 256;
        const int rowbase = lat ? b * 2048 : RL + b * 256;
        const int hid0 = lat ? (e * 8 + b) * 256 : 32768 + e * 256 + b * 32;
        unsigned key[4]; const int t0 = 4 * tid;
        if (t0 < n) { const u32x4 kv = *(const u32x4*)(af + t0); key[0] = kv.x; key[1] = kv.y; key[2] = kv.z; key[3] = kv.w; } else { key[0] = key[1] = key[2] = key[3] = 0u; }
        if (tid < 32) cnt[tid] = 0u;
        __syncthreads();
        unsigned prefix = 0u; int rem = cap;
        for (int bit = 30; bit >= 0; --bit) {
            const unsigned want = (prefix >> bit) | 1u;
            int c = 0;
#pragma unroll
            for (int j = 0; j < 4; ++j) c += ((key[j] >> bit) == want) ? 1 : 0;
            c = wave_sum_i(c);
            if (lane == 0 && c) __hip_atomic_fetch_add(&cnt[bit], (unsigned)c, __ATOMIC_RELAXED, __HIP_MEMORY_SCOPE_WORKGROUP);
            __syncthreads();
            const int tot = (int)cnt[bit];
            if (tot >= rem) prefix |= (1u << bit); else rem -= tot;
        }
        int eqc = 0;
#pragma unroll
        for (int j = 0; j < 4; ++j) eqc += (key[j] == prefix) ? 1 : 0;
        int dummy; int eqb = block_excl_scan(eqc, wtot, lane, wave, dummy);
        bool sel[4]; int selc = 0;
#pragma unroll
        for (int j = 0; j < 4; ++j) { bool s = key[j] > prefix; if (key[j] == prefix) { s = eqb < rem; ++eqb; } sel[j] = s; selc += s ? 1 : 0; }
        int slot = block_excl_scan(selc, wtot, lane, wave, dummy);
        if (t0 < n) {
#pragma unroll
            for (int j = 0; j < 4; ++j) { const int row = rowbase + t0 + j;
                if (sel[j]) { IDX[hid0 + slot] = row; GV[hid0 + slot] = __uint_as_float(key[j]); INV[(size_t)row * 16 + e] = hid0 + slot; ++slot; }
                else INV[(size_t)row * 16 + e] = -1; }
        }
        __syncthreads();
    }
}

__device__ __forceinline__ void ph_prep(const Args& a, int l, bool last, LAS unsigned char* lds, int G, int wg, int wv) {
    const int tid = tid_opaque(wv), lane = tid & 63, wave = __builtin_amdgcn_readfirstlane(tid >> 6);
    const bf16* Z = (const bf16*)(a.ws + WS_R1); bf16* Y = (bf16*)(a.ws + WS_Y);
    LAS float* vln = (LAS float*)lds;
    const int nch = last ? 128 : 144;
    for (int ck = wg; ck < nch; ck += G) {
        const int r0 = ck * 128;
        {
            const f32x4 g = *(const f32x4*)(a.in[I_SGUG] + l * 256 + 4 * lane), bb = *(const f32x4*)(a.in[I_SGUB] + l * 256 + 4 * lane);
            for (int i = 0; i < 16; ++i) { const int r = wave * 16 + i; const u32x2 w = *(const u32x2*)(Z + (size_t)(r0 + r) * ZC + 256 + 4 * lane);
                f32x4 x = {bflo(w.x), bfhi(w.x), bflo(w.y), bfhi(w.y)};
                const float mean = wave_sum((x[0] + x[1]) + (x[2] + x[3])) * (1.f / 256.f); x = x - mean;
                const float var = wave_sum((x[0] * x[0] + x[1] * x[1]) + (x[2] * x[2] + x[3] * x[3])) * (1.f / 256.f);
                const float rstd = 1.0f / sqrtf(var + LN_EPS);
                *(LAS f32x4*)(vln + r * 256 + 4 * lane) = x * rstd * g + bb; }
        }
        __syncthreads();
        {
            const int g = wave & 3, ph = wave >> 2, c = g * 64 + lane;
            const float* W = a.in[I_WSP] + ((size_t)(l * 4 + g) * 128) * 128; const float* bsp = a.in[I_BSP] + (l * 4 + g) * 128;
            for (int pb = 0; pb < 16; ++pb) {
                const int p0 = ph * 64 + pb * 4; float acc[4] = {0.f, 0.f, 0.f, 0.f};
                for (int q = 0; q < 128; q += 4) {
                    f32x4 w4[4];
#pragma unroll
                    for (int i = 0; i < 4; ++i) w4[i] = *(const f32x4*)(W + (size_t)(p0 + i) * 128 + q);
#pragma unroll
                    for (int qq = 0; qq < 4; ++qq) { const float vq = vln[(q + qq) * 256 + c];
#pragma unroll
                        for (int i = 0; i < 4; ++i) acc[i] += w4[i][qq] * vq; }
                }
#pragma unroll
                for (int i = 0; i < 4; ++i) { const int p = p0 + i; const float uu = bf2f(Z[(size_t)(r0 + p) * ZC + c]);
                    Y[(size_t)(r0 + p) * YC + c] = f2bf(uu * (acc[i] + bsp[p])); }
            }
        }
        {
            const int c = tid & 255, h0 = (tid >> 8) * 64; const int seqlen = r0 < RL ? 2048 : 256;
            const float w0 = a.in[I_CONVW][(l * 3 + 0) * 256 + c], w1 = a.in[I_CONVW][(l * 3 + 1) * 256 + c], w2 = a.in[I_CONVW][(l * 3 + 2) * 256 + c];
            auto yv = [&](int row) -> float { return bf2f(Z[(size_t)row * ZC + 768 + c]) * bf2f(Z[(size_t)row * ZC + 1024 + c]); };
            const int rs = r0 + h0;
            float prev = (rs % seqlen) != 0 ? yv(rs - 1) : 0.f, cur = yv(rs);
            for (int i = 0; i < 64; ++i) { const int row = rs + i; const float nxt = ((row + 1) % seqlen) != 0 ? yv(row + 1) : 0.f;
                const float gb = bf2f(Z[(size_t)row * ZC + 512 + c]);
                Y[(size_t)row * YC + 256 + c] = f2bf(gb * (w0 * prev + w1 * cur + w2 * nxt)); prev = cur; cur = nxt; }
        }
        __syncthreads();
    }
}

__device__ __forceinline__ void ph_ada(const Args& a, LAS unsigned char* lds, int G, int wg, int wv) {
    const int tid = tid_opaque(wv);
    LAS float* sc = (LAS float*)lds; LAS float* red = sc + 9 * 1024;
    for (int i = tid; i < 9 * 1024; i += 512) { const int bc = i >> 10, k = i & 1023; const float v = bc < 8 ? a.in[I_C][bc * 1024 + k] : a.in[I_CCTX][k]; sc[i] = v / (1.f + expf(-v)); }
    __syncthreads();
    float* ADA = (float*)(a.ws + WS_ADA);
    for (int u = wg; u < 96; u += G) {
        const int l = u / 24, cb = u % 24, cl = tid & 255, col = cb * 256 + cl, kh = tid >> 8;
        const float* w = a.in[I_WADA] + (size_t)l * 1024 * 6144 + col;
        float acc[9];
#pragma unroll
        for (int bc = 0; bc < 9; ++bc) acc[bc] = 0.f;
#pragma unroll 8
        for (int k = kh * 512; k < kh * 512 + 512; ++k) { const float wv = w[(size_t)k * 6144];
#pragma unroll
            for (int bc = 0; bc < 9; ++bc) acc[bc] += sc[bc * 1024 + k] * wv; }
        if (kh == 1) {
#pragma unroll
            for (int bc = 0; bc < 9; ++bc) red[cl * 9 + bc] = acc[bc]; }
        __syncthreads();
        if (kh == 0) { const float bv = a.in[I_BADA][l * 6144 + col];
#pragma unroll
            for (int bc = 0; bc < 9; ++bc) ADA[(size_t)(l * 9 + bc) * 6144 + col] = acc[bc] + red[cl * 9 + bc] + bv; }
        __syncthreads();
    }
}
template <class RowMap>
__device__ __forceinline__ void transpose_item(const float* W, int ldw, int k0, int n0, const RowMap& rm, LAS float* scr, int lane) {
#pragma unroll 8
    for (int i = 0; i < 32; ++i) { const int kk = 2 * i + (lane >> 5); scr[kk * 33 + (lane & 31)] = W[(size_t)(k0 + kk) * ldw + n0 + (lane & 31)]; }
    LDS_WAIT(); asm volatile("" ::: "memory");
    const int c = lane & 7;
#pragma unroll
    for (int j = 0; j < 4; ++j) { const int n = (lane >> 3) + 8 * j; const LAS float* s = scr + (8 * c) * 33 + n;
        u32x4 o; o.x = cvt_pk_bf16(s[0 * 33], s[1 * 33]); o.y = cvt_pk_bf16(s[2 * 33], s[3 * 33]); o.z = cvt_pk_bf16(s[4 * 33], s[5 * 33]); o.w = cvt_pk_bf16(s[6 * 33], s[7 * 33]);
        *(u32x4*)(rm(n0 + n) + k0 + 8 * c) = o; }
    LDS_WAIT(); asm volatile("" ::: "memory");
}
__device__ __forceinline__ void ph_weights(const Args& a, LAS unsigned char* lds, int G, int wg, int wv) {
    const int tid = tid_opaque(wv), lane = tid & 63, wave = __builtin_amdgcn_readfirstlane(tid >> 6), gw = wg * 8 + wave, NGW = G * 8;
    LAS float* scr = (LAS float*)(lds + wave * 16384);
    constexpr int C0 = 1408, C1 = C0 + 2048, C2 = C1 + 128, C3 = C2 + 128, C4 = C3 + 256, C5 = C4 + 128, C6 = C5 + 512, C7 = C6 + 512, C8 = C7 + 8192, C9 = C8 + 8192, C10 = C9 + 8192;
    for (int it = gw; it < NL * C10; it += NGW) {
        const int l = it / C10, r = it % C10;
        unsigned char* wl = a.ws + WS_W + (size_t)l * WL_STRIDE;
        if (r < C0) { const int kb = r / 88, nb = r % 88; bf16* dst = (bf16*)(wl + WL_IN);
            transpose_item(a.in[I_WIN] + (size_t)l * D * 3072, 3072, kb * 64, nb * 32, [=](int n) { return dst + (size_t)n * D; }, scr, lane); }
        else if (r < C1) { const int q = r - C0, kb = q / 128, nb = q % 128; bf16* dst = (bf16*)(wl + WL_G);
            transpose_item(a.in[I_WGATE] + (size_t)l * D * 4096, 4096, kb * 64, nb * 32,
                           [=](int n) { const int br = n >> 10, cc = n & 1023; return dst + (size_t)(((br >> 1) * 8 + (cc >> 7)) * 256 + (br & 1) * 128 + (cc & 127)) * D; }, scr, lane); }
        else if (r < C5) { int q, br, K; if (r < C2) { q = r - C1; br = 0; K = 256; } else if (r < C3) { q = r - C2; br = 1; K = 256; } else if (r < C4) { q = r - C3; br = 2; K = 512; } else { q = r - C4; br = 3; K = 256; }
            const float* src = a.in[I_WPA + br] + (size_t)l * K * D; const int kb = q / 32, nb = q % 32; bf16* dst = (bf16*)(wl + WL_P) + (size_t)br * 1024 * 512;
            transpose_item(src, D, kb * 64, nb * 32, [=](int n) { return dst + (size_t)n * 512; }, scr, lane); }
        else if (r < C7) { const int q = (r - C5) & 511, half = (r - C5) >> 9, kb = q / 32, nb = q % 32; bf16* dst = (bf16*)(wl + WL_O) + half * 1024;
            transpose_item(a.in[I_WO] + (size_t)l * D * D, D, kb * 64, nb * 32, [=](int n) { return dst + (size_t)n * M2C; }, scr, lane); }
        else if (r < C9) { const int up = r >= C8 ? 1 : 0, q = r - (up ? C8 : C7), e = q >> 9, qq = q & 511, kb = qq / 32, nb = qq % 32; bf16* dst = (bf16*)(wl + WL_GU) + (size_t)e * 2048 * D;
            transpose_item(a.in[up ? I_WEU : I_WEG] + ((size_t)l * NE + e) * D * D, D, kb * 64, nb * 32, [=](int n) { return dst + (size_t)((n >> 7) * 256 + up * 128 + (n & 127)) * D; }, scr, lane); }
        else { const int q = r - C9, e = q >> 9, qq = q & 511, kb = qq / 32, nb = qq % 32; bf16* dst = (bf16*)(wl + WL_D) + (size_t)e * D * D;
            transpose_item(a.in[I_WED] + ((size_t)l * NE + e) * D * D, D, kb * 64, nb * 32, [=](int n) { return dst + (size_t)n * D; }, scr, lane); }
    }
    __syncthreads();
    LAS float* ct = (LAS float*)lds;
    LAS float* wt = ct + 2048;
    for (int i = tid; i < 2048; i += 512) ct[i] = cospif((float)i * (1.f / 1024.f));
    __syncthreads();
    {
        bf16* FL = (bf16*)(a.ws + WS_FLAT); bf16* FC = (bf16*)(a.ws + WS_FCTX);
        const float sL = 0.022097086912079608f  , sC = 0.0625f  ;
        for (size_t i = (size_t)wg * 512 + tid; i < (size_t)2048 * 4096; i += (size_t)G * 512) { const int k1 = (int)(i >> 12), kk = (int)(i & 4095);
            const int n = kk & 2047, m = (k1 * n) & 2047; const float v = kk < 2048 ? ct[m] : -ct[(m + 1536) & 2047];
            FL[i] = f2bf(v * sL); }
        for (int i = wg * 512 + tid; i < 256 * 512; i += G * 512) { const int k1 = i >> 9, kk = i & 511; const int n = kk & 255, m = ((k1 * n) & 255) * 8;
            const float v = kk < 256 ? ct[m] : -ct[(m + 1536) & 2047]; FC[i] = f2bf(v * sC); }
    }
    {
        float* rc = (float*)(a.ws + WS_ROPE); float* rs = rc + 2048 * 32;
        for (int i = wg * 512 + tid; i < 2048 * 32; i += G * 512) { const int t = i >> 5, p = i & 31; const int j = p & 15;
            const float inv = powf(10000.0f, -(float)(2 * j) / 32.0f); const float pos = p < 16 ? (float)(t >> 6) : (float)(t & 63); const float ang = pos * inv;
            rc[i] = cosf(ang); rs[i] = sinf(ang); }
        if (wg == 0 && tid < NL) { const int l = tid; float s1 = 0.f, s2 = 0.f;
            for (int k = 0; k < 64; ++k) { s1 += a.in[I_LQ1][l * 64 + k] * a.in[I_LK1][l * 64 + k]; s2 += a.in[I_LQ2][l * 64 + k] * a.in[I_LK2][l * 64 + k]; }
            ((float*)(a.ws + WS_LAM))[l] = expf(s1) - expf(s2) + (0.8f - 0.6f * expf(-0.3f * (float)l)); }
    }
    for (int u = wg; u < NL * 64; u += G) {
        const int l = u >> 6, k0 = (u & 63) * 16;
        __syncthreads();
        for (int i = tid; i < 16 * 256; i += 512) wt[i] = a.in[I_WIN][((size_t)l * D + k0 + (i >> 8)) * 3072 + 2816 + (i & 255)];
        __syncthreads();
        const int o = tid, ty = o >> 8, g = (o >> 6) & 3, k2 = o & 63;
        float acc[16];
#pragma unroll
        for (int kr = 0; kr < 16; ++kr) acc[kr] = 0.f;
        for (int c = 0; c < 64; ++c) { const int m = ((k2 * c) & 63) * 32; const float tw = ty == 0 ? ct[m] : ct[(m + 1536) & 2047];
#pragma unroll
            for (int kr = 0; kr < 16; ++kr) acc[kr] += wt[kr * 256 + g * 64 + c] * tw; }
        bf16* dst = (bf16*)(a.ws + WS_W + (size_t)l * WL_STRIDE + WL_IN) + (size_t)(2816 + o) * D + k0;
        u32x4 w0, w1;
        w0.x = cvt_pk_bf16(acc[0] * 0.125f, acc[1] * 0.125f); w0.y = cvt_pk_bf16(acc[2] * 0.125f, acc[3] * 0.125f); w0.z = cvt_pk_bf16(acc[4] * 0.125f, acc[5] * 0.125f); w0.w = cvt_pk_bf16(acc[6] * 0.125f, acc[7] * 0.125f);
        w1.x = cvt_pk_bf16(acc[8] * 0.125f, acc[9] * 0.125f); w1.y = cvt_pk_bf16(acc[10] * 0.125f, acc[11] * 0.125f); w1.z = cvt_pk_bf16(acc[12] * 0.125f, acc[13] * 0.125f); w1.w = cvt_pk_bf16(acc[14] * 0.125f, acc[15] * 0.125f);
        *(u32x4*)dst = w0; *(u32x4*)(dst + 8) = w1;
    }
    __syncthreads();
}

constexpr int LDS_BYTES = 147456, MISC_OFF = 131072 + 320;
constexpr int NPH = 3 + NL * 10;
__global__ void __launch_bounds__(512, 2) fwd_kernel(Args a_unused) {
    extern __shared__ __attribute__((aligned(16))) unsigned char lds_raw[];
    LAS unsigned char* lds = (LAS unsigned char*)lds_raw;
    const int tid = threadIdx.x, G = gridDim.x, wg = blockIdx.x, wv = __builtin_amdgcn_readfirstlane(threadIdx.x >> 6);
    volatile LAS unsigned* MISC = (volatile LAS unsigned*)(lds + MISC_OFF);
    if (tid < 32) MISC[tid] = 0u;
    __syncthreads();
    XcdBarrier bar; bar.bar = nullptr; bar.x = 0; bar.st = nullptr;
    int lo, hi;
    { const Args& a = fresh_args(); unsigned* barw = (unsigned*)(a.ws + WS_CTL) + CW_BAR; bar.bar = barw; lo = a.ph_lo; hi = a.ph_hi;
      if (MK_N_LAUNCHES == 1) bar = xcd_barrier_post(barw, MISC + 8); }
#ifndef PHASE_MASK
#define PHASE_MASK 0xFFFFu
#endif
#define PM(j) (((PHASE_MASK) >> (j)) & 1)
#define IN(k) (lo <= (k) && (k) < hi)
#define SEAM(k) do { if (MK_N_LAUNCHES == 1 && IN((k) + 1)) { XcdBarrier b2_ = bar; asm volatile("" : "+s"(b2_.bar)); xcd_barrier(b2_, wv); } } while (0)
#ifndef MIX_MASK
#define MIX_MASK 7
#endif
#define WSP(T, off) ((T*)(a.ws + (off)))
#define WLP(off) ((const bf16*)(a.ws + WS_W + (size_t)l * WL_STRIDE + (off)))

    if (PM(10) && IN(0)) { const Args& a = fresh_args(); ph_ada(a, lds, G, wg, wv); __syncthreads(); ph_weights(a, lds, G, wg, wv); SEAM(0); }
    if (PM(11) && IN(1)) { const Args& a = fresh_args(); ph_ln<0>(a, 0, false, lds, G, wg, wv); SEAM(1); }
#pragma unroll 1
    for (int l = 0; l < NL; ++l) {
        const bool last = (l == NL - 1); const int pb = 3 + l * 10; const int npan = last ? 64 : 72;
        if (PM(0) && IN(pb + 0)) {
            const Args& a = fresh_args();
            SchedIn S{WSP(const bf16, WS_HL), WLP(WL_IN), G, wg, last};
            EpiIn E{WSP(bf16, WS_R1), WSP(bf16, WS_ZT), WSP(const float, WS_ROPE), WSP(const float, WS_ROPE) + 2048 * 32};
            gemm_phase(lds, S, E, wv); SEAM(pb + 0);
        }
        if (PM(1) && IN(pb + 1)) {
            if (MIX_MASK & 1) {
                const Args& a = fresh_args();
                const float lam = WSP(const float, WS_LAM)[l]; const float osc = 1.0f - (0.8f - 0.6f * expf(-0.3f * (float)l));
                const float* subg = a.in[I_SUBLN] + l * 128;
                const bf16* Zb = WSP(const bf16, WS_R1); float* O1b = WSP(float, WS_R2); bf16* Yb = WSP(bf16, WS_Y);
                const int nun = last ? 256 : 288;
                for (int u = wg; u < nun; u += G) {
                    int qrow0, crow0, lrow0, nt, h;
                    if (u < 256) { const int b = u >> 5; h = (u >> 3) & 3; qrow0 = b * 2048 + (u & 7) * 256; crow0 = RL + b * 256; lrow0 = b * 2048; nt = 36; }
                    else { const int q = u - 256, b = q >> 2; h = q & 3; qrow0 = RL + b * 256; crow0 = qrow0; lrow0 = 0; nt = 4; }
                    attn_pass<0>(Zb, O1b, qrow0, crow0, lrow0, 4, nt, h, (LAS char*)lds, wv);
                    attn_pass<1>(Zb, O1b, qrow0, crow0, lrow0, 4, nt, h, (LAS char*)lds, wv);
                    attn_combine(O1b, Yb, qrow0, h, lam, osc, subg, wv);
                }
                __syncthreads();
            }
            if (MIX_MASK & 2) { const Args& a = fresh_args(); SchedFourier S{WSP(const bf16, WS_FLAT), WSP(const bf16, WS_FCTX), WSP(const bf16, WS_ZT), G, (wg + 128) % G, last}; EpiStoreBf16 E{WSP(bf16, WS_Y), YC}; gemm_phase(lds, S, E, wv); }
            __syncthreads();
            if (MIX_MASK & 4) { const Args& a = fresh_args(); ph_prep(a, l, last, lds, G, (wg + 64) % G, wv); }
            SEAM(pb + 1);
        }
        if (PM(2) && IN(pb + 2)) { const Args& a = fresh_args(); SchedP S{WSP(const bf16, WS_Y), WLP(WL_P), G, wg, npan}; EpiStoreBf16 E{WSP(bf16, WS_R2), PC}; gemm_phase(lds, S, E, wv); SEAM(pb + 2); }
        if (PM(3) && IN(pb + 3)) { const Args& a = fresh_args(); SchedGate S{WSP(const bf16, WS_HL), WLP(WL_G), G, wg, npan}; EpiGate E{WSP(const bf16, WS_R2), WSP(bf16, WS_R1), a.in[I_BGATE] + l * 4096}; gemm_phase(lds, S, E, wv); SEAM(pb + 3); }
        if (PM(4) && IN(pb + 4)) { const Args& a = fresh_args(); SchedWo S{WSP(const bf16, WS_R1), WLP(WL_O), G, wg, npan}; EpiF32 E{WSP(float, WS_R2), D}; gemm_phase(lds, S, E, wv); SEAM(pb + 4); }
        if (PM(5) && IN(pb + 5)) { const Args& a = fresh_args(); ph_ln<1>(a, l, last, lds, G, wg, wv); SEAM(pb + 5); }
        if (PM(6) && IN(pb + 6)) { const Args& a = fresh_args(); ph_topk(a, last, lds, G, wg, wv); SEAM(pb + 6); }
        if (PM(7) && IN(pb + 7)) { const Args& a = fresh_args(); SchedE1 S{WSP(const bf16, WS_HL), WLP(WL_GU), WSP(const int, WS_IDX), G, wg, last ? 128 : 144}; EpiSwiglu E{WSP(bf16, WS_R1)}; gemm_phase(lds, S, E, wv); SEAM(pb + 7); }
        if (PM(8) && IN(pb + 8)) { const Args& a = fresh_args(); SchedE2 S{WSP(const bf16, WS_R1), WLP(WL_D), G, wg, last ? 128 : 144}; EpiDown E{WSP(bf16, WS_R2 + 72 * MiB), WSP(const float, WS_GV)}; gemm_phase(lds, S, E, wv); SEAM(pb + 8); }
        if (PM(9) && IN(pb + 9)) { const Args& a = fresh_args(); ph_ln<2>(a, l, last, lds, G, wg, wv); if (!last) SEAM(pb + 9); }
    }
#undef IN
#undef SEAM
}

extern "C" void kernel_launch(void* const* d_in, const int* in_sizes, int n_in, void* d_out, int out_size, void* d_ws, size_t ws_size, hipStream_t stream) {
    static int grid = 0;
    if (grid == 0) {
        if (n_in != 32 || in_sizes[0] != RL * D || out_size != RL * D || ws_size < WS_END) { fprintf(stderr, "kernel_launch: unexpected shapes (n_in %d, in0 %d, out %d, ws %zu < %zu)\n", n_in, n_in > 0 ? in_sizes[0] : -1, out_size, ws_size, (size_t)WS_END); grid = -1; return; }
        int dev = 0, cus = 0, per_cu = 0;
        if (hipGetDevice(&dev) != hipSuccess || hipDeviceGetAttribute(&cus, hipDeviceAttributeMultiprocessorCount, dev) != hipSuccess) { grid = -1; return; }
        if (hipFuncSetAttribute((const void*)fwd_kernel, hipFuncAttributeMaxDynamicSharedMemorySize, LDS_BYTES) != hipSuccess) { fprintf(stderr, "kernel_launch: hipFuncSetAttribute failed\n"); grid = -1; return; }
        if (hipOccupancyMaxActiveBlocksPerMultiprocessor(&per_cu, (const void*)fwd_kernel, 512, LDS_BYTES) != hipSuccess || per_cu < 1) fprintf(stderr, "kernel_launch: occupancy query says %d\n", per_cu);
        (void)hipGetLastError();
        grid = cus;
    }
    if (grid < 0) return;
    if (hipMemsetAsync((char*)d_ws + WS_CTL, 0, CTL_ZERO_BYTES, stream) != hipSuccess) return;
    Args a{};
    for (int i = 0; i < 32; ++i) a.in[i] = (const float*)d_in[i];
    a.out = (float*)d_out; a.ws = (unsigned char*)d_ws;
#if MK_N_LAUNCHES == 1
    a.ph_lo = 0; a.ph_hi = NPH;
    hipLaunchKernelGGL(fwd_kernel, dim3(grid), dim3(512), LDS_BYTES, stream, a);
#else
    for (int p = 0; p < NPH; ++p) { if (p == 2) continue; a.ph_lo = p; a.ph_hi = p + 1; hipLaunchKernelGGL(fwd_kernel, dim3(grid), dim3(512), LDS_BYTES, stream, a); }
#endif
    const hipError_t le = hipPeekAtLastError();
    if (le != hipSuccess) fprintf(stderr, "kernel_launch: launch failed: %s\n", hipGetErrorName(le));
}
```

```cpp
#include <hip/hip_runtime.h>
#include <cstdio>
#include <cstdint>

#ifndef MK_N_LAUNCHES
#define MK_N_LAUNCHES 1
#endif
#ifndef GEMM_FAST
#define GEMM_FAST 0
#endif

#define GAS __attribute__((address_space(1)))
#define LAS __attribute__((address_space(3)))
typedef unsigned short bf16;
typedef short bf16x8 __attribute__((ext_vector_type(8)));
typedef short s16x4 __attribute__((ext_vector_type(4)));
typedef float f32x4 __attribute__((ext_vector_type(4)));
typedef float f32x2 __attribute__((ext_vector_type(2)));
typedef float f32x16 __attribute__((ext_vector_type(16)));
typedef unsigned u32x4 __attribute__((ext_vector_type(4)));
typedef unsigned u32x2 __attribute__((ext_vector_type(2)));

constexpr int D = 1024, NB = 8, SEQ = 2048, CTXL = 256, NL = 4;
constexpr int RL = NB * SEQ, RC = NB * CTXL, R = RL + RC;
constexpr int ZC = 3328, YC = 1280, PC = 4096, M2C = 2048;
constexpr int NE = 16, CAPL = 256, CAPC = 32;
constexpr int HROWS = NE * NB * CAPL + NE * NB * CAPC;
constexpr float LN_EPS = 1e-5f, RMS_EPS = 1e-5f, DN_ALPHA = 1.6817928305074290f;

constexpr size_t MiB = 1u << 20;
constexpr size_t WS_CTL = 0, CTL_ZERO_BYTES = 1 * MiB;
constexpr size_t WS_ADA = 1 * MiB;
constexpr size_t WS_LAM = 2 * MiB;
constexpr size_t WS_ROPE = 3 * MiB;
constexpr size_t WS_FCTX = 4 * MiB;
constexpr size_t WS_AFF = 5 * MiB;
constexpr size_t WS_IDX = 7 * MiB;
constexpr size_t WS_GV = 7 * MiB + 512 * 1024;
constexpr size_t WS_INV = 8 * MiB;
constexpr size_t WS_FLAT = 10 * MiB;
constexpr size_t WS_ZT = 26 * MiB;
constexpr size_t WS_X = 44 * MiB;
constexpr size_t WS_HL = 116 * MiB;
constexpr size_t WS_Y = 152 * MiB;
constexpr size_t WS_R1 = 197 * MiB;
constexpr size_t WS_R2 = 314 * MiB;
constexpr size_t WS_W = 458 * MiB;
constexpr size_t WL_IN = 0, WL_G = 7 * MiB, WL_P = 15 * MiB, WL_O = 19 * MiB, WL_GU = 23 * MiB, WL_D = 87 * MiB, WL_STRIDE = 119 * MiB;
constexpr size_t WS_END = WS_W + 4 * WL_STRIDE;
constexpr int CW_BAR = 4096;

__device__ __forceinline__ unsigned cvt_pk_bf16(float lo, float hi) { unsigned r; asm volatile("v_cvt_pk_bf16_f32 %0, %1, %2" : "=v"(r) : "v"(lo), "v"(hi)); return r; }
__device__ __forceinline__ float bf2f(unsigned short b) { return __uint_as_float((unsigned)b << 16); }
__device__ __forceinline__ float bflo(unsigned w) { return __uint_as_float(w << 16); }
__device__ __forceinline__ float bfhi(unsigned w) { return __uint_as_float(w & 0xffff0000u); }
__device__ __forceinline__ unsigned short f2bf(float f) { return (unsigned short)(cvt_pk_bf16(f, 0.f) & 0xffffu); }
__device__ __forceinline__ float wave_sum(float v) {
#pragma unroll
    for (int o = 1; o < 64; o <<= 1) v += __shfl_xor(v, o);
    return v;
}
__device__ __forceinline__ int wave_sum_i(int v) {
#pragma unroll
    for (int o = 1; o < 64; o <<= 1) v += __shfl_xor(v, o);
    return v;
}
__device__ __forceinline__ float sigmoid_f(float x) { return __builtin_amdgcn_rcpf(1.f + __expf(-x)); }
__device__ __forceinline__ float gelu_tanh(float x) { const float y = 0.7978845608028654f * (x + 0.044715f * x * x * x); return x * sigmoid_f(2.f * y); }
#define LDS_WAIT() asm volatile("s_waitcnt lgkmcnt(0)" ::: "memory")
#define VM_WAIT() asm volatile("s_waitcnt vmcnt(0)" ::: "memory")

__device__ __forceinline__ int tid_opaque(int wv) { unsigned z = 0u; asm volatile("" : "+v"(z)); return wv * 64 + (int)__builtin_amdgcn_mbcnt_hi(~0u, __builtin_amdgcn_mbcnt_lo(~0u, z)); }
#define XB_TMO      128
#define XB_XCNT(j)  (256  + 64 * (j))
#define XB_XSUB(j)  (1280 + 64 * (j))
#define XB_XGEN(j)  (2304 + 64 * (j))
#define XB_TOP      3328
#define XB_TOPGEN   3392
#define XCD_BAR_WORDS 3456
#define XB_SPIN_CAP (1u << 22)
__device__ __forceinline__ unsigned xb_ld(unsigned* p)              { return __hip_atomic_load(p, __ATOMIC_RELAXED, __HIP_MEMORY_SCOPE_AGENT); }
__device__ __forceinline__ unsigned xb_add(unsigned* p, unsigned v) { return __hip_atomic_fetch_add(p, v, __ATOMIC_RELAXED, __HIP_MEMORY_SCOPE_AGENT); }
__device__ __forceinline__ unsigned xb_xcc_id() { return (unsigned)__builtin_amdgcn_s_getreg((3 << 11) | 20) & 0xFu; }
#define XB_SPIN(cond, bar) do { unsigned _sp = 0; while (cond) { __builtin_amdgcn_s_sleep(1); \
    if ((++_sp & 255u) == 0u) { if (xb_ld(&(bar)[XB_TMO])) break; if (_sp > XB_SPIN_CAP) { atomicAdd(&(bar)[XB_TMO], 1u); break; } } } } while (0)
struct XcdBarrier { unsigned* bar; unsigned x; volatile LAS unsigned* st; };
__device__ __forceinline__ XcdBarrier xcd_barrier_post(unsigned* bar, volatile LAS unsigned* st) {
    XcdBarrier b; b.bar = bar; b.x = xb_xcc_id(); b.st = st;
    if (threadIdx.x == 0) (void)xb_add(&bar[XB_XCNT(b.x)], 1u);
    return b;
}
__device__ __forceinline__ void xcd_barrier_complete(unsigned* bar, unsigned x, unsigned& nloc, unsigned& nx) {
    const unsigned G = gridDim.x * gridDim.y * gridDim.z;
    unsigned sum, cnt, mine, sp = 0u;
    for (;;) {
        sum = 0u; cnt = 0u; mine = 0u;
#pragma unroll
        for (unsigned j = 0; j < 16; ++j) { const unsigned c = xb_ld(&bar[XB_XCNT(j)]); sum += c; cnt += (c > 0u) ? 1u : 0u; mine = (j == x) ? c : mine; }
        if (sum == G) break;
        __builtin_amdgcn_s_sleep(1);
        if ((++sp & 255u) == 0u) { if (xb_ld(&bar[XB_TMO])) break; if (sp > XB_SPIN_CAP) { atomicAdd(&bar[XB_TMO], 1u); break; } }
    }
    nloc = mine > 0u ? mine : 1u; nx = cnt > 0u ? cnt : 1u;
}
__device__ __forceinline__ void xcd_barrier(const XcdBarrier& b, int wv) {
    asm volatile("s_waitcnt vmcnt(0)" ::: "memory");
    __syncthreads();
    if (tid_opaque(wv) == 0) {
        unsigned* bar = b.bar;
        __builtin_amdgcn_s_waitcnt(0);
        unsigned nloc = b.st[0], nx = b.st[1];
        if (nloc == 0u) { xcd_barrier_complete(bar, b.x, nloc, nx); b.st[0] = nloc; b.st[1] = nx; }
        const unsigned old = xb_add(&bar[XB_XSUB(b.x)], 1u);
        const unsigned gen = old / nloc;
        if (old + 1u == (gen + 1u) * nloc) {
            __builtin_amdgcn_fence(__ATOMIC_RELEASE, "agent");
            asm volatile("s_waitcnt vmcnt(0)" ::: "memory");
            const unsigned og = xb_add(&bar[XB_TOP], 1u);
            const unsigned tg = og / nx;
            if (og + 1u == (tg + 1u) * nx) xb_add(&bar[XB_TOPGEN], 1u);
            else XB_SPIN(xb_ld(&bar[XB_TOPGEN]) == tg, bar);
            __builtin_amdgcn_fence(__ATOMIC_ACQUIRE, "agent");
            xb_add(&bar[XB_XGEN(b.x)], 1u);
            asm volatile("s_waitcnt vmcnt(0)" ::: "memory");
        } else {
            XB_SPIN(xb_ld(&bar[XB_XGEN(b.x)]) == gen, bar);
            __builtin_amdgcn_fence(__ATOMIC_ACQUIRE, "agent");
            asm volatile("s_waitcnt vmcnt(0)" ::: "memory");
        }
    }
    __syncthreads();
}

struct Args { const float* in[32]; float* out; unsigned char* ws; int ph_lo, ph_hi; };
enum { I_X = 0, I_C, I_CTX, I_CCTX, I_WADA, I_BADA, I_WIN, I_WGATE, I_BGATE, I_SGUG, I_SGUB, I_WSP, I_BSP, I_CONVW, I_LQ1, I_LK1, I_LQ2, I_LK2, I_SUBLN,
       I_WPA, I_WPB, I_WPC, I_WPD, I_WO, I_LN1G, I_LN1B, I_WROUTER, I_WEG, I_WEU, I_WED, I_LN2G, I_LN2B };

__device__ __forceinline__ const Args& fresh_args() { auto p = (const __attribute__((address_space(4))) Args*)__builtin_amdgcn_kernarg_segment_ptr(); asm volatile("" : "+s"(p)); return *(const Args*)p; }
struct Unit { const bf16* A; const bf16* B; const int* gidx; int lda, ldb, K, pm, pn, aux; };
__device__ __forceinline__ int perm32(int rho) { const int n = rho >> 4, i = rho & 15; return 8 * (i >> 2) + 4 * n + (i & 3); }

template <class Epi, class Sched>
__device__ __forceinline__ void gemm_phase_simple(LAS unsigned char* lds, const Sched& S, const Epi& E, int wv) {
    const int tid = tid_opaque(wv), wid = __builtin_amdgcn_readfirstlane(tid >> 6), lane = tid & 63, wr = wid >> 2, wc = wid & 3, fr = lane & 15, fq = lane >> 4;
    Unit u;
    for (int i = 0; S.next(i, u); ++i) {
        f32x4 acc[2][2][4][2];
#pragma unroll
        for (int a = 0; a < 2; ++a)
#pragma unroll
            for (int b = 0; b < 2; ++b)
#pragma unroll
                for (int m = 0; m < 4; ++m)
#pragma unroll
                    for (int n = 0; n < 2; ++n) acc[a][b][m][n] = (f32x4){0.f, 0.f, 0.f, 0.f};
        unsigned ao[2][4], bo[2][2];
#pragma unroll
        for (int ai = 0; ai < 2; ++ai)
#pragma unroll
            for (int m = 0; m < 4; ++m) { const int r = ai * 128 + wr * 64 + m * 16 + fr; const unsigned gr = u.gidx ? (unsigned)u.gidx[r] : (unsigned)r; ao[ai][m] = gr * (unsigned)u.lda + fq * 8; }
#pragma unroll
        for (int bj = 0; bj < 2; ++bj)
#pragma unroll
            for (int n = 0; n < 2; ++n) { const int slot = n * 16 + fr; const int rr = Epi::PERM ? perm32(slot) : slot; bo[bj][n] = (unsigned)(bj * 128 + wc * 32 + rr) * (unsigned)u.ldb + fq * 8; }
        for (int k0 = 0; k0 < u.K; k0 += 64) {
#pragma unroll
            for (int ai = 0; ai < 2; ++ai) {
                bf16x8 At[4][2];
#pragma unroll
                for (int m = 0; m < 4; ++m)
#pragma unroll
                    for (int k = 0; k < 2; ++k) At[m][k] = *(const bf16x8*)(u.A + k0 + k * 32 + ao[ai][m]);
#pragma unroll
                for (int bj = 0; bj < 2; ++bj) {
                    bf16x8 Bf[2][2];
#pragma unroll
                    for (int n = 0; n < 2; ++n)
#pragma unroll
                        for (int k = 0; k < 2; ++k) Bf[n][k] = *(const bf16x8*)(u.B + k0 + k * 32 + bo[bj][n]);
#pragma unroll
                    for (int m = 0; m < 4; ++m)
#pragma unroll
                        for (int n = 0; n < 2; ++n)
#pragma unroll
                            for (int k = 0; k < 2; ++k) acc[ai][bj][m][n] = __builtin_amdgcn_mfma_f32_16x16x32_bf16(Bf[n][k], At[m][k], acc[ai][bj][m][n], 0, 0, 0);
                }
            }
        }
        E(acc, u, wr, wc, fr, fq);
    }
}


constexpr int HTB = 128 * 64 * 2, GATHER_OFF = 131072 + 1024;
__device__ __forceinline__ int lds_byte(int r, int c) { const int st = (r >> 4) * 2 + (c >> 5), rr = r & 15, cc = c & 31, ob = rr * 64 + cc * 2; return st * 1024 + (ob ^ (((ob >> 9) & 1) << 5)); }
__device__ __forceinline__ void stage_rc(int b, int& Rr, int& Cc) { const int st = b / 1024, sb = b % 1024, swz = sb ^ (((sb >> 9) & 1) << 5); Rr = (st >> 1) * 16 + swz / 64; Cc = (st & 1) * 32 + (swz % 64) / 2; }
template <class Epi, class Sched>
__device__ __forceinline__ void gemm_phase(LAS unsigned char* lds, const Sched& S, const Epi& E, int wv) {
    const int tid = tid_opaque(wv), wid = __builtin_amdgcn_readfirstlane(tid >> 6), lane = tid & 63, wr = wid >> 2, wc = wid & 3, fr = lane & 15, fq = lane >> 4;
    Unit cur, nxt; int ui = 0;
    if (!S.next(0, cur)) return;
    if (Sched::GATHER) {
        LAS int* gl = (LAS int*)(lds + GATHER_OFF);
        Unit t_;
        for (int i = 0; S.next(i, t_); ++i) if (tid < 256) gl[i * 256 + tid] = t_.gidx[tid];
        __syncthreads();
    }
    int sR[2], sC[2], sRb[2];
#pragma unroll
    for (int i = 0; i < 2; ++i) { int Rr, Cc; stage_rc(tid * 16 + i * 8192, Rr, Cc); sR[i] = Rr; sC[i] = Cc; sRb[i] = Epi::PERM ? ((Rr & ~31) + perm32(Rr & 31)) : Rr; }
    const unsigned ldsw = (unsigned)wid * 1024u;
    const int aoff = lds_byte(wr * 64 + fr, fq * 8), boff = lds_byte(wc * 32 + fr, fq * 8);
    unsigned vA[2][2], vB[2]; size_t hB;
#define G_OFFS(u_, ui_) do { _Pragma("unroll") for (int h_ = 0; h_ < 2; ++h_) _Pragma("unroll") for (int i_ = 0; i_ < 2; ++i_) { const int r_ = h_ * 128 + sR[i_]; \
        const unsigned gr_ = Sched::GATHER ? (unsigned)((LAS int*)(lds + GATHER_OFF))[(ui_) * 256 + r_] : (unsigned)r_; vA[h_][i_] = (gr_ * (unsigned)(u_).lda + (unsigned)sC[i_]) * 2u; } \
        _Pragma("unroll") for (int i_ = 0; i_ < 2; ++i_) vB[i_] = ((unsigned)sRb[i_] * (unsigned)(u_).ldb + (unsigned)sC[i_]) * 2u; hB = (size_t)(u_).ldb * 256; } while (0)
#define G_SA(b, h) (((b) * 2 + (h)) * HTB)
#define G_SB(b, h) ((4 + (b) * 2 + (h)) * HTB)
#define G_STAGE(bufoff, gbase, voff) do { _Pragma("unroll") for (int _i = 0; _i < 2; ++_i) \
        __builtin_amdgcn_global_load_lds((const unsigned*)((const char*)(gbase) + (voff)[_i]), (LAS unsigned*)(lds + (bufoff) + ldsw + _i * 8192), 16, 0, 0); } while (0)
#define G_LDA(dst, b, h) do { _Pragma("unroll") for (int m = 0; m < 4; ++m) _Pragma("unroll") for (int k = 0; k < 2; ++k) dst[m][k] = *(const LAS bf16x8*)(lds + G_SA(b, h) + aoff + m * 2048 + k * 1024); } while (0)
#define G_LDB(dst, b, h) do { _Pragma("unroll") for (int n = 0; n < 2; ++n) _Pragma("unroll") for (int k = 0; k < 2; ++k) dst[n][k] = *(const LAS bf16x8*)(lds + G_SB(b, h) + boff + n * 2048 + k * 1024); } while (0)
#define G_MMA(ai, bj, At_, Bt_) do { __builtin_amdgcn_s_setprio(1); _Pragma("unroll") for (int m = 0; m < 4; ++m) _Pragma("unroll") for (int n = 0; n < 2; ++n) _Pragma("unroll") for (int k = 0; k < 2; ++k) \
        acc[ai][bj][m][n] = __builtin_amdgcn_mfma_f32_16x16x32_bf16(Bt_[n][k], At_[m][k], acc[ai][bj][m][n], 0, 0, 0); __builtin_amdgcn_s_setprio(0); } while (0)
#define G_WAIT_V(n) asm volatile("s_waitcnt vmcnt(" #n ")" ::: "memory")
#define G_WAIT_L(n) asm volatile("s_waitcnt lgkmcnt(" #n ")" ::: "memory")
#define G_BAR __builtin_amdgcn_s_barrier()
#define G_SCHED __builtin_amdgcn_sched_barrier(0)
    f32x4 acc[2][2][4][2];
#pragma unroll
    for (int a = 0; a < 2; ++a)
#pragma unroll
        for (int b = 0; b < 2; ++b)
#pragma unroll
            for (int m = 0; m < 4; ++m)
#pragma unroll
                for (int n = 0; n < 2; ++n) acc[a][b][m][n] = (f32x4){0.f, 0.f, 0.f, 0.f};
    bf16x8 At[4][2], B0[2][2], B1[2][2];
    const char* cA = (const char*)cur.A; const char* cB = (const char*)cur.B;
    const size_t kstep = 128;
    G_OFFS(cur, 0);
    G_STAGE(G_SB(0, 0), cB, vB); G_STAGE(G_SB(0, 1), cB + hB, vB); G_STAGE(G_SA(0, 0), cA, vA[0]); G_STAGE(G_SA(0, 1), cA, vA[1]);
    if (wr == 1) G_BAR;
    G_WAIT_V(2); G_BAR;
    G_STAGE(G_SB(1, 0), cB + kstep, vB); G_STAGE(G_SA(1, 0), cA + kstep, vA[0]); G_STAGE(G_SB(1, 1), cB + hB + kstep, vB);
    G_WAIT_V(6); G_BAR;
    for (;;) {
        const bool has_next = S.next(ui + 1, nxt);
        const char* nA = has_next ? (const char*)nxt.A : cA; const char* nB = has_next ? (const char*)nxt.B : cB;
        const int nt = cur.K >> 6;
        for (int t = 0; t < nt; t += 2) {
            const bool last = (t == nt - 2);
            const char* a1 = cA + (size_t)(t + 1) * kstep;
            const char* a2 = last ? nA : cA + (size_t)(t + 2) * kstep; const char* b2 = last ? nB : cB + (size_t)(t + 2) * kstep;
            const char* a3 = a2 + kstep; const char* b3 = b2 + kstep;
            G_LDB(B0, 0, 0); G_LDB(B1, 0, 1); G_SCHED; G_LDA(At, 0, 0); G_STAGE(G_SA(1, 1), a1, vA[1]);
            if (last && has_next) G_OFFS(nxt, ui + 1);
            G_WAIT_V(8); G_WAIT_L(0); G_BAR; G_MMA(0, 0, At, B0); G_MMA(0, 1, At, B1); G_BAR; G_SCHED;
            G_LDA(At, 0, 1); G_STAGE(G_SB(0, 0), b2, vB); G_STAGE(G_SB(0, 1), b2 + hB, vB); G_STAGE(G_SA(0, 0), a2, vA[0]);
            G_WAIT_V(8); G_WAIT_L(0); G_BAR; G_MMA(1, 0, At, B0); G_MMA(1, 1, At, B1); G_BAR; G_SCHED;
            G_LDB(B0, 1, 0); G_LDB(B1, 1, 1); G_SCHED; G_LDA(At, 1, 0); G_STAGE(G_SA(0, 1), a2, vA[1]);
            G_WAIT_V(8); G_WAIT_L(0); G_BAR; G_MMA(0, 0, At, B0); G_MMA(0, 1, At, B1); G_BAR; G_SCHED;
            G_LDA(At, 1, 1); G_STAGE(G_SB(1, 0), b3, vB); G_STAGE(G_SB(1, 1), b3 + hB, vB); G_STAGE(G_SA(1, 0), a3, vA[0]);
            G_WAIT_V(8); G_WAIT_L(0); G_BAR; G_MMA(1, 0, At, B0); G_MMA(1, 1, At, B1); G_BAR; G_SCHED;
        }
        if (wr == 0) G_BAR;
        E(acc, cur, wr, wc, fr, fq);
        if (!has_next) break;
#pragma unroll
        for (int a = 0; a < 2; ++a)
#pragma unroll
            for (int b = 0; b < 2; ++b)
#pragma unroll
                for (int m = 0; m < 4; ++m)
#pragma unroll
                    for (int n = 0; n < 2; ++n) acc[a][b][m][n] = (f32x4){0.f, 0.f, 0.f, 0.f};
        cur = nxt; cA = nA; cB = nB; ++ui;
        if (wr == 1) G_BAR;
    }
    G_WAIT_V(0);
    G_BAR;
#undef G_OFFS
#undef G_SA
#undef G_SB
#undef G_STAGE
#undef G_LDA
#undef G_LDB
#undef G_MMA
#undef G_WAIT_V
#undef G_WAIT_L
#undef G_BAR
#undef G_SCHED
}

#define EPI_ROWS_BEGIN _Pragma("unroll") for (int ai = 0; ai < 2; ++ai) _Pragma("unroll") for (int m = 0; m < 4; ++m) { const int rl = ai * 128 + wr * 64 + m * 16 + fr;
#define EPI_ROWS_END }
__device__ __forceinline__ u32x4 pack8(const f32x4 a, const f32x4 b) { u32x4 w; w.x = cvt_pk_bf16(a[0], a[1]); w.y = cvt_pk_bf16(a[2], a[3]); w.z = cvt_pk_bf16(b[0], b[1]); w.w = cvt_pk_bf16(b[2], b[3]); return w; }
__device__ __forceinline__ void unpack8(const u32x4 w, float (&f)[8]) { f[0] = bflo(w.x); f[1] = bfhi(w.x); f[2] = bflo(w.y); f[3] = bfhi(w.y); f[4] = bflo(w.z); f[5] = bfhi(w.z); f[6] = bflo(w.w); f[7] = bfhi(w.w); }

struct EpiIn {
    static constexpr bool PERM = true;
    bf16* Z; bf16* ZT; const float* ropec; const float* ropes;
    __device__ __forceinline__ void operator()(const f32x4 (&acc)[2][2][4][2], const Unit& u, int wr, int wc, int fr, int fq) const {
        const int pn = u.pn; const bool lat = u.pm < 64;
        EPI_ROWS_BEGIN
            const int row = u.pm * 256 + rl;
#pragma unroll
            for (int bj = 0; bj < 2; ++bj) {
                const int col0 = pn * 256 + bj * 128 + wc * 32 + 8 * fq;
                f32x4 v0 = acc[ai][bj][m][0], v1 = acc[ai][bj][m][1];
                if (pn < 2) {
#pragma unroll
                    for (int j = 0; j < 4; ++j) { v0[j] = gelu_tanh(v0[j]); v1[j] = gelu_tanh(v1[j]); }
                } else if (pn >= 5 && pn <= 8 && lat) {
                    const int t = row & 2047, p0 = (col0 & 63) >> 1;
                    const f32x4 cs = *(const f32x4*)(ropec + t * 32 + p0), sn = *(const f32x4*)(ropes + t * 32 + p0);
                    const f32x4 a = v0, b = v1;
                    v0[0] = a[0] * cs[0] - a[1] * sn[0]; v0[1] = a[0] * sn[0] + a[1] * cs[0];
                    v0[2] = a[2] * cs[1] - a[3] * sn[1]; v0[3] = a[2] * sn[1] + a[3] * cs[1];
                    v1[0] = b[0] * cs[2] - b[1] * sn[2]; v1[1] = b[0] * sn[2] + b[1] * cs[2];
                    v1[2] = b[2] * cs[3] - b[3] * sn[3]; v1[3] = b[2] * sn[3] + b[3] * cs[3];
                }
                if (pn < 11) {
                    *(u32x4*)(Z + (size_t)row * ZC + col0) = pack8(v0, v1);
                } else {
                    const int cc = col0 - pn * 256;
#pragma unroll
                    for (int j = 0; j < 8; ++j) {
                        const float val = j < 4 ? v0[j & 3] : v1[j & 3];
                        size_t o;
                        if (lat) { const int b = row >> 11, n = row & 2047; o = ((size_t)(b * 256 + cc + j)) * 4096 + (pn == 12 ? 2048 : 0) + n; }
                        else { const int rc = row - RL, b = rc >> 8, n = rc & 255; o = (size_t)8 * 256 * 4096 + ((size_t)(b * 256 + cc + j)) * 512 + (pn == 12 ? 256 : 0) + n; }
                        ZT[o] = f2bf(val);
                    }
                }
            }
        EPI_ROWS_END
    }
};
struct EpiStoreBf16 {
    static constexpr bool PERM = true;
    bf16* O; int ldc;
    __device__ __forceinline__ void operator()(const f32x4 (&acc)[2][2][4][2], const Unit& u, int wr, int wc, int fr, int fq) const {
        EPI_ROWS_BEGIN
#pragma unroll
            for (int bj = 0; bj < 2; ++bj) { const int col0 = u.pn * 256 + bj * 128 + wc * 32 + 8 * fq;
                *(u32x4*)(O + (size_t)(u.aux + rl) * ldc + col0) = pack8(acc[ai][bj][m][0], acc[ai][bj][m][1]); }
        EPI_ROWS_END
    }
};
struct EpiGate {
    static constexpr bool PERM = true;
    const bf16* P; bf16* M2; const float* bgate;
    __device__ __forceinline__ void operator()(const f32x4 (&acc)[2][2][4][2], const Unit& u, int wr, int wc, int fr, int fq) const {
        const int p = u.pn >> 3, cb = (u.pn & 7) * 128 + wc * 32 + 8 * fq;
        float b0[8], b1[8];
        { const f32x4 x0 = *(const f32x4*)(bgate + (2 * p) * 1024 + cb), x1 = *(const f32x4*)(bgate + (2 * p) * 1024 + cb + 4), y0 = *(const f32x4*)(bgate + (2 * p + 1) * 1024 + cb), y1 = *(const f32x4*)(bgate + (2 * p + 1) * 1024 + cb + 4);
#pragma unroll
          for (int j = 0; j < 4; ++j) { b0[j] = x0[j]; b0[4 + j] = x1[j]; b1[j] = y0[j]; b1[4 + j] = y1[j]; } }
        EPI_ROWS_BEGIN
            const size_t row = (size_t)u.pm * 256 + rl;
            float p0[8], p1[8];
            unpack8(*(const u32x4*)(P + row * PC + (2 * p) * 1024 + cb), p0);
            unpack8(*(const u32x4*)(P + row * PC + (2 * p + 1) * 1024 + cb), p1);
            f32x4 o0, o1;
#pragma unroll
            for (int j = 0; j < 4; ++j) {
                o0[j] = sigmoid_f(acc[ai][0][m][0][j] + b0[j]) * p0[j] + sigmoid_f(acc[ai][1][m][0][j] + b1[j]) * p1[j];
                o1[j] = sigmoid_f(acc[ai][0][m][1][j] + b0[4 + j]) * p0[4 + j] + sigmoid_f(acc[ai][1][m][1][j] + b1[4 + j]) * p1[4 + j];
            }
            *(u32x4*)(M2 + row * M2C + p * 1024 + cb) = pack8(o0, o1);
        EPI_ROWS_END
    }
};
struct EpiF32 {
    static constexpr bool PERM = false;
    float* C; int ldc;
    __device__ __forceinline__ void operator()(const f32x4 (&acc)[2][2][4][2], const Unit& u, int wr, int wc, int fr, int fq) const {
        EPI_ROWS_BEGIN
            float* rowp = C + ((size_t)u.pm * 256 + rl) * ldc + u.pn * 256 + wc * 32 + 4 * fq;
#pragma unroll
            for (int bj = 0; bj < 2; ++bj)
#pragma unroll
                for (int n = 0; n < 2; ++n) *(f32x4*)(rowp + bj * 128 + n * 16) = acc[ai][bj][m][n];
        EPI_ROWS_END
    }
};
struct EpiSwiglu {
    static constexpr bool PERM = true;
    bf16* HID;
    __device__ __forceinline__ void operator()(const f32x4 (&acc)[2][2][4][2], const Unit& u, int wr, int wc, int fr, int fq) const {
        EPI_ROWS_BEGIN
            f32x4 o0, o1;
#pragma unroll
            for (int j = 0; j < 4; ++j) { const float g0 = acc[ai][0][m][0][j], g1 = acc[ai][0][m][1][j];
                o0[j] = g0 * sigmoid_f(g0) * acc[ai][1][m][0][j]; o1[j] = g1 * sigmoid_f(g1) * acc[ai][1][m][1][j]; }
            *(u32x4*)(HID + ((size_t)u.pm * 256 + rl) * 1024 + u.pn * 128 + wc * 32 + 8 * fq) = pack8(o0, o1);
        EPI_ROWS_END
    }
};
struct EpiDown {
    static constexpr bool PERM = true;
    bf16* YE; const float* GV;
    __device__ __forceinline__ void operator()(const f32x4 (&acc)[2][2][4][2], const Unit& u, int wr, int wc, int fr, int fq) const {
        EPI_ROWS_BEGIN
            const size_t row = (size_t)u.pm * 256 + rl; const float g = GV[row];
#pragma unroll
            for (int bj = 0; bj < 2; ++bj) *(u32x4*)(YE + row * 1024 + u.pn * 256 + bj * 128 + wc * 32 + 8 * fq) = pack8(acc[ai][bj][m][0] * g, acc[ai][bj][m][1] * g);
        EPI_ROWS_END
    }
};

struct SchedIn {
    static constexpr bool GATHER = false;
    const bf16* HL; const bf16* W; int G, c; bool last;
    __device__ __forceinline__ bool next(int i, Unit& u) const {
        const int idx = i * G + c; int pm, pn;
        if (!last) { if (idx >= 72 * 13) return false; pm = idx / 13; pn = idx % 13; }
        else { if (idx >= 64 * 13 + 32) return false; if (idx < 64 * 13) { pm = idx / 13; pn = idx % 13; } else { const int q = idx - 64 * 13; pm = 64 + (q >> 2); pn = 7 + (q & 3); } }
        u.A = HL + (size_t)pm * 256 * D; u.B = W + (size_t)pn * 256 * D; u.gidx = nullptr; u.lda = D; u.ldb = D; u.K = D; u.pm = pm; u.pn = pn; u.aux = 0; return true;
    }
};
struct SchedFourier {
    static constexpr bool GATHER = false;
    const bf16* FL; const bf16* FC; const bf16* ZT; int G, c; bool last;
    __device__ __forceinline__ bool next(int i, Unit& u) const {
        const int idx = i * G + c; if (idx >= (last ? 64 : 72)) return false;
        u.gidx = nullptr; u.pn = 4;
        if (idx < 64) { const int b = idx >> 3, pm = idx & 7; u.A = FL + (size_t)pm * 256 * 4096; u.B = ZT + (size_t)b * 256 * 4096; u.lda = 4096; u.ldb = 4096; u.K = 4096; u.pm = idx; u.aux = b * 2048 + pm * 256; }
        else { const int b = idx - 64; u.A = FC; u.B = ZT + (size_t)8 * 256 * 4096 + (size_t)b * 256 * 512; u.lda = 512; u.ldb = 512; u.K = 512; u.pm = idx; u.aux = RL + b * 256; }
        return true;
    }
};
struct SchedP {
    static constexpr bool GATHER = false;
    const bf16* Y; const bf16* W; int G, c, npan;
    __device__ __forceinline__ bool next(int i, Unit& u) const {
        const int idx = i * G + c; if (idx >= npan * 16) return false;
        const int pm = idx >> 4, q = idx & 15, br = q >> 2, pnl = q & 3;
        const int coff = br == 0 ? 0 : (br == 1 ? 256 : (br == 2 ? 512 : 1024));
        u.A = Y + (size_t)pm * 256 * YC + coff; u.B = W + ((size_t)br * 1024 + pnl * 256) * 512; u.gidx = nullptr; u.lda = YC; u.ldb = 512; u.K = br == 2 ? 512 : 256; u.pm = pm; u.pn = q; u.aux = pm * 256; return true;
    }
};
struct SchedGate {
    static constexpr bool GATHER = false;
    const bf16* HL; const bf16* W; int G, c, npan;
    __device__ __forceinline__ bool next(int i, Unit& u) const {
        const int idx = i * G + c; if (idx >= npan * 16) return false;
        const int pm = idx >> 4, tn = idx & 15;
        u.A = HL + (size_t)pm * 256 * D; u.B = W + (size_t)tn * 256 * D; u.gidx = nullptr; u.lda = D; u.ldb = D; u.K = D; u.pm = pm; u.pn = tn; u.aux = 0; return true;
    }
};
struct SchedWo {
    static constexpr bool GATHER = false;
    const bf16* M2; const bf16* W; int G, c, npan;
    __device__ __forceinline__ bool next(int i, Unit& u) const {
        const int idx = i * G + c; if (idx >= npan * 4) return false;
        const int pm = idx >> 2, pn = idx & 3;
        u.A = M2 + (size_t)pm * 256 * M2C; u.B = W + (size_t)pn * 256 * M2C; u.gidx = nullptr; u.lda = M2C; u.ldb = M2C; u.K = M2C; u.pm = pm; u.pn = pn; u.aux = 0; return true;
    }
};
struct SchedE1 {
    static constexpr bool GATHER = true;
    const bf16* HL; const bf16* W; const int* IDX; int G, c, npanel;
    __device__ __forceinline__ bool next(int i, Unit& u) const {
        const int idx = i * G + c; if (idx >= npanel * 8) return false;
        const int panel = idx >> 3, tn = idx & 7, e = panel < 128 ? (panel >> 3) : (panel - 128);
        u.A = HL; u.B = W + ((size_t)e * 2048 + tn * 256) * D; u.gidx = IDX + panel * 256; u.lda = D; u.ldb = D; u.K = D; u.pm = panel; u.pn = tn; u.aux = e; return true;
    }
};
struct SchedE2 {
    static constexpr bool GATHER = false;
    const bf16* HID; const bf16* W; int G, c, npanel;
    __device__ __forceinline__ bool next(int i, Unit& u) const {
        const int idx = i * G + c; if (idx >= npanel * 4) return false;
        const int panel = idx >> 2, pn = idx & 3, e = panel < 128 ? (panel >> 3) : (panel - 128);
        u.A = HID + (size_t)panel * 256 * 1024; u.B = W + ((size_t)e * 1024 + pn * 256) * 1024; u.gidx = nullptr; u.lda = 1024; u.ldb = 1024; u.K = 1024; u.pm = panel; u.pn = pn; u.aux = e; return true;
    }
};

constexpr int AT_SHM_V = 64 * 128 * 2, AT_SHM_K = 64 * 64 * 2;
#define KSWZ64(row, colB) ((row) * 128 + ((colB) ^ ((((row) >> 1) & 7) << 4)))
#define SBAR() __builtin_amdgcn_sched_barrier(0)
__device__ __forceinline__ int crow(int r, int hi) { return (r & 3) + 8 * (r >> 2) + 4 * hi; }
constexpr float AT_SCALE = 0.125f, AT_THR = 8.f;
__device__ __forceinline__ void partialSM(f32x16& p0, f32x16& p1, float& m_reg, float& mn, float& alpha) {
    constexpr float C = AT_SCALE * 1.4426950408889634f;
    float pmax = p0[0];
#pragma unroll
    for (int r = 1; r < 16; ++r) pmax = fmaxf(pmax, p0[r]);
#pragma unroll
    for (int r = 0; r < 16; ++r) pmax = fmaxf(pmax, p1[r]);
    { auto rr = __builtin_amdgcn_permlane32_swap(__float_as_uint(pmax), __float_as_uint(pmax), false, false);
      pmax = fmaxf(__uint_as_float(rr[0]), __uint_as_float(rr[1])); }
    if (__builtin_expect(__all(pmax - m_reg <= AT_THR / AT_SCALE), 1)) { mn = m_reg; alpha = 1.f; }
    else { mn = fmaxf(m_reg, pmax); alpha = __builtin_amdgcn_exp2f((m_reg - mn) * C); m_reg = mn; }
    const float mnC = -mn * C;
#pragma unroll
    for (int r = 0; r < 16; ++r) p0[r] = fmaf(p0[r], C, mnC);
#pragma unroll
    for (int r = 0; r < 16; ++r) p1[r] = fmaf(p1[r], C, mnC);
#pragma unroll
    for (int r = 0; r < 16; ++r) p0[r] = __builtin_amdgcn_exp2f(p0[r]);
}
__device__ __forceinline__ void finishSM(f32x16& p0, f32x16& p1, float alpha, float& l_reg, bf16x8& pa0, bf16x8& pa1, bf16x8& pa2, bf16x8& pa3) {
#pragma unroll
    for (int r = 0; r < 16; ++r) p1[r] = __builtin_amdgcn_exp2f(p1[r]);
    float ps = 0;
#pragma unroll
    for (int r = 0; r < 16; ++r) ps += p0[r];
#pragma unroll
    for (int r = 0; r < 16; ++r) ps += p1[r];
    { auto rr = __builtin_amdgcn_permlane32_swap(__float_as_uint(ps), __float_as_uint(ps), false, false);
      ps = __uint_as_float(rr[0]) + __uint_as_float(rr[1]); }
    l_reg = l_reg * alpha + ps;
#define PK4(P, BASE, OUT) do { unsigned a0 = cvt_pk_bf16(P[BASE + 0], P[BASE + 1]), a1 = cvt_pk_bf16(P[BASE + 2], P[BASE + 3]);   \
    unsigned b0 = cvt_pk_bf16(P[BASE + 4], P[BASE + 5]), b1 = cvt_pk_bf16(P[BASE + 6], P[BASE + 7]);                              \
    auto r0 = __builtin_amdgcn_permlane32_swap(a0, b0, false, false); auto r1 = __builtin_amdgcn_permlane32_swap(a1, b1, false, false); \
    u32x4 w = {r0[0], r1[0], r0[1], r1[1]}; OUT = *reinterpret_cast<bf16x8*>(&w); } while (0)
    PK4(p0, 0, pa0); PK4(p0, 8, pa1); PK4(p1, 0, pa2); PK4(p1, 8, pa3);
#undef PK4
}
__device__ __forceinline__ void qkt(f32x16& p0, f32x16& p1, const LAS char* Ks, const bf16x8 (&qr)[4], int r32, int hi) {
    p0 = f32x16{}; p1 = f32x16{};
#pragma unroll
    for (int d0 = 0; d0 < 4; ++d0) { const int cb = (d0 * 16 + hi * 8) * 2;
        const bf16x8 b0 = *(const LAS bf16x8*)(Ks + KSWZ64(r32, cb));
        const bf16x8 b1 = *(const LAS bf16x8*)(Ks + KSWZ64(32 + r32, cb));
        p0 = __builtin_amdgcn_mfma_f32_32x32x16_bf16(b0, qr[d0], p0, 0, 0, 0);
        p1 = __builtin_amdgcn_mfma_f32_32x32x16_bf16(b1, qr[d0], p1, 0, 0, 0); }
}
__device__ __forceinline__ int v_st(int k, int c) { const int kk = (k & ~0xC) | ((k & 4) << 1) | ((k & 8) >> 1); return ((kk >> 3) * 4 + (c >> 5)) * 512 + ((kk & 7) * 32 + (c & 31)) * 2; }
__device__ __forceinline__ int v_rd_base(int lane) { return ((lane & 3) << 3) | (((lane >> 2) & 3) << 6) | (((lane >> 4) & 1) << 5) | (((lane >> 5) & 1) << 8); }
constexpr int v_rd_off(int d0, int ks, int half) { return d0 * 512 + ks * 4096 + half * 2048; }
template <int OFF> __device__ __forceinline__ s16x4 tr_read(int vb) {
    s16x4 r; asm volatile("ds_read_b64_tr_b16 %0, %1 offset:%2" : "=&v"(r) : "v"(vb), "i"(OFF) : "memory"); return r;
}
template <int D0> __device__ __forceinline__ void pv_one(f32x16& od, int vb, bf16x8 pa0, bf16x8 pa1, bf16x8 pa2, bf16x8 pa3) {
    const s16x4 l0 = tr_read<v_rd_off(D0, 0, 0)>(vb), h0 = tr_read<v_rd_off(D0, 0, 1)>(vb), l1 = tr_read<v_rd_off(D0, 1, 0)>(vb), h1 = tr_read<v_rd_off(D0, 1, 1)>(vb);
    const s16x4 l2 = tr_read<v_rd_off(D0, 2, 0)>(vb), h2 = tr_read<v_rd_off(D0, 2, 1)>(vb), l3 = tr_read<v_rd_off(D0, 3, 0)>(vb), h3 = tr_read<v_rd_off(D0, 3, 1)>(vb);
    asm volatile("s_waitcnt lgkmcnt(0)" ::: "memory"); SBAR();
#define PK(L, H) (bf16x8){L[0], L[1], L[2], L[3], H[0], H[1], H[2], H[3]}
    od = __builtin_amdgcn_mfma_f32_32x32x16_bf16(pa0, PK(l0, h0), od, 0, 0, 0);
    od = __builtin_amdgcn_mfma_f32_32x32x16_bf16(pa1, PK(l1, h1), od, 0, 0, 0);
    od = __builtin_amdgcn_mfma_f32_32x32x16_bf16(pa2, PK(l2, h2), od, 0, 0, 0);
    od = __builtin_amdgcn_mfma_f32_32x32x16_bf16(pa3, PK(l3, h3), od, 0, 0, 0);
#undef PK
}
__device__ __forceinline__ void pv_d0(f32x16 (&o)[4], int vb, bf16x8 pa0, bf16x8 pa1, bf16x8 pa2, bf16x8 pa3) {
    pv_one<0>(o[0], vb, pa0, pa1, pa2, pa3); pv_one<1>(o[1], vb, pa0, pa1, pa2, pa3); pv_one<2>(o[2], vb, pa0, pa1, pa2, pa3); pv_one<3>(o[3], vb, pa0, pa1, pa2, pa3);
}
template <int pass> __device__ __forceinline__ void attn_pass(const bf16* Z, float* O1, int qrow0, int crow0, int lrow0, int ntc, int nt, int h, LAS char* lds, int wv) {
    const int tid = tid_opaque(wv), wid = tid >> 6, lane = tid & 63, r32 = lane & 31, hi = lane >> 5;
    LAS char* V_lds = lds; LAS char* K_lds = lds + 2 * AT_SHM_V;
    LAS float* ws = (LAS float*)(lds + 2 * AT_SHM_V + 2 * AT_SHM_K) + wid * 64; LAS float* li_l = ws; LAS float* al_l = ws + 32;
    const int sr = tid >> 4, sc = (tid & 15) * 8, vst0 = v_st(sr, sc), vst1 = v_st(32 + sr, sc);
    const int srk = tid >> 3, sck = (tid & 7) * 8;
    const int vgo0 = sr * ZC + sc, kgo0 = srk * ZC + sck, kst0 = KSWZ64(srk, sck * 2);
    const int vb0 = (int)(uintptr_t)V_lds + v_rd_base(lane);
    {
        float m_reg = -1e30f, l_reg = 0; f32x16 o[4] = {}; bf16x8 qr[4];
        const bf16* Qw = Z + (size_t)(qrow0 + wid * 32 + r32) * ZC + 1280 + h * 128 + pass * 64 + hi * 8;
#pragma unroll
        for (int d0 = 0; d0 < 4; ++d0) qr[d0] = *(const bf16x8*)(Qw + d0 * 16);
        const bf16* Kc = Z + 1792 + h * 128 + pass * 64; const bf16* Vc = Z + 2304 + h * 128;
        struct { bf16x8 vs0, vs1, ks0; } sr_[2];
#define KROW(t) ((t) < ntc ? crow0 + (t) * 64 : lrow0 + ((t) - ntc) * 64)
#define SLOAD(i, t) do { const size_t _r = (size_t)__builtin_amdgcn_readfirstlane(KROW(t)) * ZC; const bf16* _v = Vc + _r; const bf16* _k = Kc + _r; \
    sr_[i].vs0 = *(const bf16x8*)(_v + vgo0); sr_[i].vs1 = *(const bf16x8*)(_v + vgo0 + 32 * ZC); sr_[i].ks0 = *(const bf16x8*)(_k + kgo0); } while (0)
#define SWRITE(b, i) do { *(LAS bf16x8*)(V_lds + (b) * AT_SHM_V + vst0) = sr_[i].vs0; *(LAS bf16x8*)(V_lds + (b) * AT_SHM_V + vst1) = sr_[i].vs1; \
    *(LAS bf16x8*)(K_lds + (b) * AT_SHM_K + kst0) = sr_[i].ks0; } while (0)
#define SWAIT() asm volatile("s_waitcnt vmcnt(3)" ::: "memory")
#define RESC(a) do { if (__any((a) < 1.f)) { if (hi == 0) al_l[r32] = (a); asm volatile("s_waitcnt lgkmcnt(0)" ::: "memory"); \
    _Pragma("unroll") for (int d = 0; d < 4; ++d) _Pragma("unroll") for (int r = 0; r < 16; ++r) o[d][r] *= al_l[crow(r, hi)]; } } while (0)
        f32x16 pA0, pA1, pB0, pB1; float mnA, mnB, alA, alB; bf16x8 pa0, pa1, pa2, pa3;
        __syncthreads();
        SLOAD(0, 0); asm volatile("s_waitcnt vmcnt(0)" ::: "memory"); SWRITE(0, 0); __syncthreads();
        qkt(pA0, pA1, K_lds, qr, r32, hi); partialSM(pA0, pA1, m_reg, mnA, alA);
        SLOAD(1, 1); if (2 < nt) SLOAD(0, 2);
        SWAIT(); SWRITE(1, 1); __syncthreads();
        for (int j = 1; j + 1 < nt; j += 2) {
            SBAR(); qkt(pB0, pB1, K_lds + AT_SHM_K, qr, r32, hi);
            finishSM(pA0, pA1, alA, l_reg, pa0, pa1, pa2, pa3); SBAR();
            SLOAD(1, j + 2); SBAR();
            pv_d0(o, vb0, pa0, pa1, pa2, pa3); partialSM(pB0, pB1, m_reg, mnB, alB);
            __syncthreads(); SWAIT(); SWRITE(0, 0);
            RESC(alB); __syncthreads();
            SBAR(); qkt(pA0, pA1, K_lds, qr, r32, hi);
            finishSM(pB0, pB1, alB, l_reg, pa0, pa1, pa2, pa3); SBAR();
            if (j + 3 < nt) SLOAD(0, j + 3); SBAR();
            pv_d0(o, vb0 + AT_SHM_V, pa0, pa1, pa2, pa3); partialSM(pA0, pA1, m_reg, mnA, alA);
            __syncthreads(); SWAIT(); SWRITE(1, 1);
            RESC(alA); __syncthreads();
        }
        SBAR(); qkt(pB0, pB1, K_lds + AT_SHM_K, qr, r32, hi);
        finishSM(pA0, pA1, alA, l_reg, pa0, pa1, pa2, pa3); SBAR();
        pv_d0(o, vb0, pa0, pa1, pa2, pa3); partialSM(pB0, pB1, m_reg, mnB, alB);
        __syncthreads(); RESC(alB);
        finishSM(pB0, pB1, alB, l_reg, pa0, pa1, pa2, pa3); SBAR();
        pv_d0(o, vb0 + AT_SHM_V, pa0, pa1, pa2, pa3);
        if (hi == 0) li_l[r32] = l_reg; asm volatile("s_waitcnt lgkmcnt(0)" ::: "memory");
#pragma unroll
        for (int r = 0; r < 16; ++r) { const float rl_ = __builtin_amdgcn_rcpf(li_l[crow(r, hi)]);
#pragma unroll
            for (int d0 = 0; d0 < 4; ++d0) o[d0][r] *= rl_; }
        const int orow0 = qrow0 + wid * 32;
        float* Op = O1 + (size_t)pass * ((size_t)R * 512);
#pragma unroll
        for (int r = 0; r < 16; ++r)
#pragma unroll
            for (int d0 = 0; d0 < 4; ++d0) Op[(size_t)(orow0 + crow(r, hi)) * 512 + h * 128 + d0 * 32 + r32] = o[d0][r];
    }
#undef KROW
#undef SLOAD
#undef SWRITE
#undef SWAIT
#undef RESC
}
__device__ __forceinline__ void attn_combine(float* O1, bf16* Y, int qrow0, int h, float lam, float osc, const float* subg, int wv) {
    const int tid = tid_opaque(wv), wid = tid >> 6, lane = tid & 63;
    asm volatile("s_waitcnt vmcnt(0)" ::: "memory");
    {
        const float* O2 = O1 + (size_t)R * 512; const int orow0 = qrow0 + wid * 32;
        const float g0 = subg[lane] * osc, g1 = subg[64 + lane] * osc;
        for (int rr = 0; rr < 32; ++rr) {
            const size_t o_ = (size_t)(orow0 + rr) * 512 + h * 128 + lane;
            const float a0 = __hip_atomic_load(O1 + o_, __ATOMIC_RELAXED, __HIP_MEMORY_SCOPE_AGENT), a1 = __hip_atomic_load(O1 + o_ + 64, __ATOMIC_RELAXED, __HIP_MEMORY_SCOPE_AGENT);
            const float b0 = __hip_atomic_load(O2 + o_, __ATOMIC_RELAXED, __HIP_MEMORY_SCOPE_AGENT), b1 = __hip_atomic_load(O2 + o_ + 64, __ATOMIC_RELAXED, __HIP_MEMORY_SCOPE_AGENT);
            const float v0 = a0 - lam * b0, v1 = a1 - lam * b1;
            const float ss = wave_sum(v0 * v0 + v1 * v1);
            const float rs = 1.0f / sqrtf(ss * (1.f / 128.f) + RMS_EPS);
            bf16* yr = Y + (size_t)(orow0 + rr) * YC + 512 + h * 128 + lane;
            yr[0] = f2bf(v0 * rs * g0); yr[64] = f2bf(v1 * rs * g1);
        }
    }
}

__device__ __forceinline__ void row_stats(const f32x4 (&v)[4], float& mean, float& rstd) {
    float s = 0.f;
#pragma unroll
    for (int j = 0; j < 4; ++j) s += (v[j][0] + v[j][1]) + (v[j][2] + v[j][3]);
    mean = wave_sum(s) * (1.f / D); float q = 0.f;
#pragma unroll
    for (int j = 0; j < 4; ++j) { const f32x4 d = v[j] - mean; q += (d[0] * d[0] + d[1] * d[1]) + (d[2] * d[2] + d[3] * d[3]); }
    rstd = 1.0f / sqrtf(wave_sum(q) * (1.f / D) + LN_EPS);
}
__device__ __forceinline__ void store_h(bf16* HLrow, const f32x4 (&v)[4], float mean, float rstd, const float* shift, const float* scale, int lane) {
#pragma unroll
    for (int j = 0; j < 4; ++j) { const int c = 4 * lane + 256 * j; const f32x4 sh = *(const f32x4*)(shift + c), sc = *(const f32x4*)(scale + c);
        const f32x4 h = (v[j] - mean) * rstd * (sc + 1.f) + sh; u32x2 w; w.x = cvt_pk_bf16(h[0], h[1]); w.y = cvt_pk_bf16(h[2], h[3]); *(u32x2*)(HLrow + c) = w; }
}
template <int MODE>
__device__ __forceinline__ void ph_ln(const Args& a, int l, bool last, LAS unsigned char* lds, int G, int wg, int wv) {
    const int tid = tid_opaque(wv), lane = tid & 63, wave = tid >> 6, gw = wg * 8 + wave, NGW = G * 8;
    float* X = (float*)(a.ws + WS_X); bf16* HL = (bf16*)(a.ws + WS_HL); const float* ADA = (const float*)(a.ws + WS_ADA);
    LAS float* wr_l = (LAS float*)lds;
    if (MODE == 1) {
        const float* wrt = a.in[I_WROUTER] + (size_t)l * D * NE;
        for (int i = tid; i < D * NE; i += 512) { const int k = i >> 4, e = i & 15; wr_l[e * D + k] = wrt[i]; }
        __syncthreads();
    }
    const int nrows = (MODE != 0 && last) ? RL : R;
    for (int row = gw; row < nrows; row += NGW) {
        const int bc = row < RL ? (row >> 11) : 8;
        f32x4 v[4]; float mean, rstd;
        if (MODE == 0) {
            const float* src = row < RL ? a.in[I_X] + (size_t)row * D : a.in[I_CTX] + (size_t)(row - RL) * D;
#pragma unroll
            for (int j = 0; j < 4; ++j) { v[j] = *(const f32x4*)(src + 4 * lane + 256 * j); *(f32x4*)(X + (size_t)row * D + 4 * lane + 256 * j) = v[j]; }
            row_stats(v, mean, rstd);
            const float* ad = ADA + (size_t)(0 * 9 + bc) * 6144;
            store_h(HL + (size_t)row * D, v, mean, rstd, ad, ad + 1024, lane);
        } else {
            const float* ad = ADA + (size_t)(l * 9 + bc) * 6144;
            const float* gate = ad + (MODE == 1 ? 2048 : 5120);
            if (MODE == 1) {
                const float* T = (const float*)(a.ws + WS_R2) + (size_t)row * D;
#pragma unroll
                for (int j = 0; j < 4; ++j) { const int c = 4 * lane + 256 * j; v[j] = *(const f32x4*)(X + (size_t)row * D + c) * DN_ALPHA + *(const f32x4*)(gate + c) * *(const f32x4*)(T + c); }
            } else {
                const int* INV = (const int*)(a.ws + WS_INV) + (size_t)row * 16; const bf16* YE = (const bf16*)(a.ws + WS_R2 + 72 * MiB);
                const int myinv = lane < 16 ? INV[lane] : -1;
                f32x4 mo[4];
#pragma unroll
                for (int j = 0; j < 4; ++j) mo[j] = (f32x4){0.f, 0.f, 0.f, 0.f};
                for (int e = 0; e < 16; ++e) { const int r = __shfl(myinv, e);
                    if (r >= 0) {
#pragma unroll
                        for (int j = 0; j < 4; ++j) { const u32x2 w = *(const u32x2*)(YE + (size_t)r * 1024 + 4 * lane + 256 * j); mo[j][0] += bflo(w.x); mo[j][1] += bfhi(w.x); mo[j][2] += bflo(w.y); mo[j][3] += bfhi(w.y); }
                    } }
#pragma unroll
                for (int j = 0; j < 4; ++j) { const int c = 4 * lane + 256 * j; v[j] = *(const f32x4*)(X + (size_t)row * D + c) * DN_ALPHA + *(const f32x4*)(gate + c) * mo[j]; }
            }
            row_stats(v, mean, rstd);
            const float* g = a.in[MODE == 1 ? I_LN1G : I_LN2G] + l * D; const float* b = a.in[MODE == 1 ? I_LN1B : I_LN2B] + l * D;
#pragma unroll
            for (int j = 0; j < 4; ++j) { const int c = 4 * lane + 256 * j; v[j] = (v[j] - mean) * rstd * *(const f32x4*)(g + c) + *(const f32x4*)(b + c); *(f32x4*)(X + (size_t)row * D + c) = v[j];
                if (MODE == 2 && last) *(f32x4*)(a.out + (size_t)row * D + c) = v[j]; }
            if (MODE == 1 || !last) {
                row_stats(v, mean, rstd);
                const float* ad2 = MODE == 1 ? ad + 3072 : ADA + (size_t)((l + 1) * 9 + bc) * 6144;
                store_h(HL + (size_t)row * D, v, mean, rstd, ad2, ad2 + 1024, lane);
                if (MODE == 1) {
                    float lg[16];
#pragma unroll
                    for (int e = 0; e < 16; ++e) lg[e] = 0.f;
#pragma unroll
                    for (int j = 0; j < 4; ++j) { const int c = 4 * lane + 256 * j; const f32x4 sh = *(const f32x4*)(ad2 + c), sc = *(const f32x4*)(ad2 + 1024 + c);
                        const f32x4 h = (v[j] - mean) * rstd * (sc + 1.f) + sh;
#pragma unroll
                        for (int e = 0; e < 16; ++e) { const f32x4 w = *(const LAS f32x4*)(wr_l + e * D + c); lg[e] += (h[0] * w[0] + h[1] * w[1]) + (h[2] * w[2] + h[3] * w[3]); } }
                    float mx = -1e30f;
#pragma unroll
                    for (int e = 0; e < 16; ++e) { lg[e] = wave_sum(lg[e]); mx = fmaxf(mx, lg[e]); }
                    float se = 0.f;
#pragma unroll
                    for (int e = 0; e < 16; ++e) { lg[e] = expf(lg[e] - mx); se += lg[e]; }
                    float mine = 0.f;
#pragma unroll
                    for (int e = 0; e < 16; ++e) mine = (lane == e) ? lg[e] : mine;
                    float* AFF = (float*)(a.ws + WS_AFF);
                    if (lane < 16) {
                        if (row < RL) AFF[((size_t)(row >> 11) * 16 + lane) * 2048 + (row & 2047)] = mine / se;
                        else { const int rc = row - RL; AFF[(size_t)8 * 16 * 2048 + ((size_t)(rc >> 8) * 16 + lane) * 256 + (rc & 255)] = mine / se; }
                    }
                }
            }
        }
    }
}

__device__ __forceinline__ int block_excl_scan(int v, LAS int* wtot, int lane, int wave, int& total) {
    int inc = v;
#pragma unroll
    for (int o = 1; o < 64; o <<= 1) { const int t = __shfl_up(inc, o); if (lane >= o) inc += t; }
    if (lane == 63) wtot[wave] = inc;
    __syncthreads();
    int base = 0, tot = 0;
#pragma unroll
    for (int w = 0; w < 8; ++w) { const int x = wtot[w]; tot += x; if (w < wave) base += x; }
    __syncthreads();
    total = tot; return base + inc - v;
}
__device__ __forceinline__ void ph_topk(const Args& a, bool last, LAS unsigned char* lds, int G, int wg, int wv) {
    const int tid = tid_opaque(wv), lane = tid & 63, wave = tid >> 6;
    LAS unsigned* cnt = (LAS unsigned*)lds; LAS int* wtot = (LAS int*)(lds + 256);
    const float* AFF = (const float*)(a.ws + WS_AFF); int* IDX = (int*)(a.ws + WS_IDX); float* GV = (float*)(a.ws + WS_GV); int* INV = (int*)(a.ws + WS_INV);
    const int nunits = last ? 128 : 256;
    for (int u = wg; u < nunits; u += G) {
        const bool lat = u < 128; const int b = lat ? (u >> 4) : ((u - 128) >> 4), e = u & 15;
        const int n = lat ? 2048 : 256, cap = lat ? CAPL : CAPC;
        const float* af = lat ? AFF + ((size_t)b * 16 + e) * 2048 : AFF + (size_t)8 * 16 * 2048 + ((size_t)b * 16 + e) * 256;
        const int rowbase = lat ? b * 2048 : RL + b * 256;
        const int hid0 = lat ? (e * 8 + b) * 256 : 32768 + e * 256 + b * 32;
        unsigned key[4]; const int t0 = 4 * tid;
        if (t0 < n) { const u32x4 kv = *(const u32x4*)(af + t0); key[0] = kv.x; key[1] = kv.y; key[2] = kv.z; key[3] = kv.w; } else { key[0] = key[1] = key[2] = key[3] = 0u; }
        if (tid < 32) cnt[tid] = 0u;
        __syncthreads();
        unsigned prefix = 0u; int rem = cap;
        for (int bit = 30; bit >= 0; --bit) {
            const unsigned want = (prefix >> bit) | 1u;
            int c = 0;
#pragma unroll
            for (int j = 0; j < 4; ++j) c += ((key[j] >> bit) == want) ? 1 : 0;
            c = wave_sum_i(c);
            if (lane == 0 && c) __hip_atomic_fetch_add(&cnt[bit], (unsigned)c, __ATOMIC_RELAXED, __HIP_MEMORY_SCOPE_WORKGROUP);
            __syncthreads();
            const int tot = (int)cnt[bit];
            if (tot >= rem) prefix |= (1u << bit); else rem -= tot;
        }
        int eqc = 0;
#pragma unroll
        for (int j = 0; j < 4; ++j) eqc += (key[j] == prefix) ? 1 : 0;
        int dummy; int eqb = block_excl_scan(eqc, wtot, lane, wave, dummy);
        bool sel[4]; int selc = 0;
#pragma unroll
        for (int j = 0; j < 4; ++j) { bool s = key[j] > prefix; if (key[j] == prefix) { s = eqb < rem; ++eqb; } sel[j] = s; selc += s ? 1 : 0; }
        int slot = block_excl_scan(selc, wtot, lane, wave, dummy);
        if (t0 < n) {
#pragma unroll
            for (int j = 0; j < 4; ++j) { const int row = rowbase + t0 + j;
                if (sel[j]) { IDX[hid0 + slot] = row; GV[hid0 + slot] = __uint_as_float(key[j]); INV[(size_t)row * 16 + e] = hid0 + slot; ++slot; }
                else INV[(size_t)row * 16 + e] = -1; }
        }
        __syncthreads();
    }
}

__device__ __forceinline__ void ph_prep(const Args& a, int l, bool last, LAS unsigned char* lds, int G, int wg, int wv) {
    const int tid = tid_opaque(wv), lane = tid & 63, wave = __builtin_amdgcn_readfirstlane(tid >> 6);
    const bf16* Z = (const bf16*)(a.ws + WS_R1); bf16* Y = (bf16*)(a.ws + WS_Y);
    LAS float* vln = (LAS float*)lds;
    const int nch = last ? 128 : 144;
    for (int ck = wg; ck < nch; ck += G) {
        const int r0 = ck * 128;
        {
            const f32x4 g = *(const f32x4*)(a.in[I_SGUG] + l * 256 + 4 * lane), bb = *(const f32x4*)(a.in[I_SGUB] + l * 256 + 4 * lane);
            for (int i = 0; i < 16; ++i) { const int r = wave * 16 + i; const u32x2 w = *(const u32x2*)(Z + (size_t)(r0 + r) * ZC + 256 + 4 * lane);
                f32x4 x = {bflo(w.x), bfhi(w.x), bflo(w.y), bfhi(w.y)};
                const float mean = wave_sum((x[0] + x[1]) + (x[2] + x[3])) * (1.f / 256.f); x = x - mean;
                const float var = wave_sum((x[0] * x[0] + x[1] * x[1]) + (x[2] * x[2] + x[3] * x[3])) * (1.f / 256.f);
                const float rstd = 1.0f / sqrtf(var + LN_EPS);
                *(LAS f32x4*)(vln + r * 256 + 4 * lane) = x * rstd * g + bb; }
        }
        __syncthreads();
        {
            const int g = wave & 3, ph = wave >> 2, c = g * 64 + lane;
            const float* W = a.in[I_WSP] + ((size_t)(l * 4 + g) * 128) * 128; const float* bsp = a.in[I_BSP] + (l * 4 + g) * 128;
            for (int pb = 0; pb < 16; ++pb) {
                const int p0 = ph * 64 + pb * 4; float acc[4] = {0.f, 0.f, 0.f, 0.f};
                for (int q = 0; q < 128; q += 4) {
                    f32x4 w4[4];
#pragma unroll
                    for (int i = 0; i < 4; ++i) w4[i] = *(const f32x4*)(W + (size_t)(p0 + i) * 128 + q);
#pragma unroll
                    for (int qq = 0; qq < 4; ++qq) { const float vq = vln[(q + qq) * 256 + c];
#pragma unroll
                        for (int i = 0; i < 4; ++i) acc[i] += w4[i][qq] * vq; }
                }
#pragma unroll
                for (int i = 0; i < 4; ++i) { const int p = p0 + i; const float uu = bf2f(Z[(size_t)(r0 + p) * ZC + c]);
                    Y[(size_t)(r0 + p) * YC + c] = f2bf(uu * (acc[i] + bsp[p])); }
            }
        }
        {
            const int c = tid & 255, h0 = (tid >> 8) * 64; const int seqlen = r0 < RL ? 2048 : 256;
            const float w0 = a.in[I_CONVW][(l * 3 + 0) * 256 + c], w1 = a.in[I_CONVW][(l * 3 + 1) * 256 + c], w2 = a.in[I_CONVW][(l * 3 + 2) * 256 + c];
            auto yv = [&](int row) -> float { return bf2f(Z[(size_t)row * ZC + 768 + c]) * bf2f(Z[(size_t)row * ZC + 1024 + c]); };
            const int rs = r0 + h0;
            float prev = (rs % seqlen) != 0 ? yv(rs - 1) : 0.f, cur = yv(rs);
            for (int i = 0; i < 64; ++i) { const int row = rs + i; const float nxt = ((row + 1) % seqlen) != 0 ? yv(row + 1) : 0.f;
                const float gb = bf2f(Z[(size_t)row * ZC + 512 + c]);
                Y[(size_t)row * YC + 256 + c] = f2bf(gb * (w0 * prev + w1 * cur + w2 * nxt)); prev = cur; cur = nxt; }
        }
        __syncthreads();
    }
}

__device__ __forceinline__ void ph_ada(const Args& a, LAS unsigned char* lds, int G, int wg, int wv) {
    const int tid = tid_opaque(wv);
    LAS float* sc = (LAS float*)lds; LAS float* red = sc + 9 * 1024;
    for (int i = tid; i < 9 * 1024; i += 512) { const int bc = i >> 10, k = i & 1023; const float v = bc < 8 ? a.in[I_C][bc * 1024 + k] : a.in[I_CCTX][k]; sc[i] = v / (1.f + expf(-v)); }
    __syncthreads();
    float* ADA = (float*)(a.ws + WS_ADA);
    for (int u = wg; u < 96; u += G) {
        const int l = u / 24, cb = u % 24, cl = tid & 255, col = cb * 256 + cl, kh = tid >> 8;
        const float* w = a.in[I_WADA] + (size_t)l * 1024 * 6144 + col;
        float acc[9];
#pragma unroll
        for (int bc = 0; bc < 9; ++bc) acc[bc] = 0.f;
#pragma unroll 8
        for (int k = kh * 512; k < kh * 512 + 512; ++k) { const float wv = w[(size_t)k * 6144];
#pragma unroll
            for (int bc = 0; bc < 9; ++bc) acc[bc] += sc[bc * 1024 + k] * wv; }
        if (kh == 1) {
#pragma unroll
            for (int bc = 0; bc < 9; ++bc) red[cl * 9 + bc] = acc[bc]; }
        __syncthreads();
        if (kh == 0) { const float bv = a.in[I_BADA][l * 6144 + col];
#pragma unroll
            for (int bc = 0; bc < 9; ++bc) ADA[(size_t)(l * 9 + bc) * 6144 + col] = acc[bc] + red[cl * 9 + bc] + bv; }
        __syncthreads();
    }
}
template <class RowMap>
__device__ __forceinline__ void transpose_item(const float* W, int ldw, int k0, int n0, const RowMap& rm, LAS float* scr, int lane) {
#pragma unroll 8
    for (int i = 0; i < 32; ++i) { const int kk = 2 * i + (lane >> 5); scr[kk * 33 + (lane & 31)] = W[(size_t)(k0 + kk) * ldw + n0 + (lane & 31)]; }
    LDS_WAIT(); asm volatile("" ::: "memory");
    const int c = lane & 7;
#pragma unroll
    for (int j = 0; j < 4; ++j) { const int n = (lane >> 3) + 8 * j; const LAS float* s = scr + (8 * c) * 33 + n;
        u32x4 o; o.x = cvt_pk_bf16(s[0 * 33], s[1 * 33]); o.y = cvt_pk_bf16(s[2 * 33], s[3 * 33]); o.z = cvt_pk_bf16(s[4 * 33], s[5 * 33]); o.w = cvt_pk_bf16(s[6 * 33], s[7 * 33]);
        *(u32x4*)(rm(n0 + n) + k0 + 8 * c) = o; }
    LDS_WAIT(); asm volatile("" ::: "memory");
}
__device__ __forceinline__ void ph_weights(const Args& a, LAS unsigned char* lds, int G, int wg, int wv) {
    const int tid = tid_opaque(wv), lane = tid & 63, wave = __builtin_amdgcn_readfirstlane(tid >> 6), gw = wg * 8 + wave, NGW = G * 8;
    LAS float* scr = (LAS float*)(lds + wave * 16384);
    constexpr int C0 = 1408, C1 = C0 + 2048, C2 = C1 + 128, C3 = C2 + 128, C4 = C3 + 256, C5 = C4 + 128, C6 = C5 + 512, C7 = C6 + 512, C8 = C7 + 8192, C9 = C8 + 8192, C10 = C9 + 8192;
    for (int it = gw; it < NL * C10; it += NGW) {
        const int l = it / C10, r = it % C10;
        unsigned char* wl = a.ws + WS_W + (size_t)l * WL_STRIDE;
        if (r < C0) { const int kb = r / 88, nb = r % 88; bf16* dst = (bf16*)(wl + WL_IN);
            transpose_item(a.in[I_WIN] + (size_t)l * D * 3072, 3072, kb * 64, nb * 32, [=](int n) { return dst + (size_t)n * D; }, scr, lane); }
        else if (r < C1) { const int q = r - C0, kb = q / 128, nb = q % 128; bf16* dst = (bf16*)(wl + WL_G);
            transpose_item(a.in[I_WGATE] + (size_t)l * D * 4096, 4096, kb * 64, nb * 32,
                           [=](int n) { const int br = n >> 10, cc = n & 1023; return dst + (size_t)(((br >> 1) * 8 + (cc >> 7)) * 256 + (br & 1) * 128 + (cc & 127)) * D; }, scr, lane); }
        else if (r < C5) { int q, br, K; if (r < C2) { q = r - C1; br = 0; K = 256; } else if (r < C3) { q = r - C2; br = 1; K = 256; } else if (r < C4) { q = r - C3; br = 2; K = 512; } else { q = r - C4; br = 3; K = 256; }
            const float* src = a.in[I_WPA + br] + (size_t)l * K * D; const int kb = q / 32, nb = q % 32; bf16* dst = (bf16*)(wl + WL_P) + (size_t)br * 1024 * 512;
            transpose_item(src, D, kb * 64, nb * 32, [=](int n) { return dst + (size_t)n * 512; }, scr, lane); }
        else if (r < C7) { const int q = (r - C5) & 511, half = (r - C5) >> 9, kb = q / 32, nb = q % 32; bf16* dst = (bf16*)(wl + WL_O) + half * 1024;
            transpose_item(a.in[I_WO] + (size_t)l * D * D, D, kb * 64, nb * 32, [=](int n) { return dst + (size_t)n * M2C; }, scr, lane); }
        else if (r < C9) { const int up = r >= C8 ? 1 : 0, q = r - (up ? C8 : C7), e = q >> 9, qq = q & 511, kb = qq / 32, nb = qq % 32; bf16* dst = (bf16*)(wl + WL_GU) + (size_t)e * 2048 * D;
            transpose_item(a.in[up ? I_WEU : I_WEG] + ((size_t)l * NE + e) * D * D, D, kb * 64, nb * 32, [=](int n) { return dst + (size_t)((n >> 7) * 256 + up * 128 + (n & 127)) * D; }, scr, lane); }
        else { const int q = r - C9, e = q >> 9, qq = q & 511, kb = qq / 32, nb = qq % 32; bf16* dst = (bf16*)(wl + WL_D) + (size_t)e * D * D;
            transpose_item(a.in[I_WED] + ((size_t)l * NE + e) * D * D, D, kb * 64, nb * 32, [=](int n) { return dst + (size_t)n * D; }, scr, lane); }
    }
    __syncthreads();
    LAS float* ct = (LAS float*)lds;
    LAS float* wt = ct + 2048;
    for (int i = tid; i < 2048; i += 512) ct[i] = cospif((float)i * (1.f / 1024.f));
    __syncthreads();
    {
        bf16* FL = (bf16*)(a.ws + WS_FLAT); bf16* FC = (bf16*)(a.ws + WS_FCTX);
        const float sL = 0.022097086912079608f  , sC = 0.0625f  ;
        for (size_t i = (size_t)wg * 512 + tid; i < (size_t)2048 * 4096; i += (size_t)G * 512) { const int k1 = (int)(i >> 12), kk = (int)(i & 4095);
            const int n = kk & 2047, m = (k1 * n) & 2047; const float v = kk < 2048 ? ct[m] : -ct[(m + 1536) & 2047];
            FL[i] = f2bf(v * sL); }
        for (int i = wg * 512 + tid; i < 256 * 512; i += G * 512) { const int k1 = i >> 9, kk = i & 511; const int n = kk & 255, m = ((k1 * n) & 255) * 8;
            const float v = kk < 256 ? ct[m] : -ct[(m + 1536) & 2047]; FC[i] = f2bf(v * sC); }
    }
    {
        float* rc = (float*)(a.ws + WS_ROPE); float* rs = rc + 2048 * 32;
        for (int i = wg * 512 + tid; i < 2048 * 32; i += G * 512) { const int t = i >> 5, p = i & 31; const int j = p & 15;
            const float inv = powf(10000.0f, -(float)(2 * j) / 32.0f); const float pos = p < 16 ? (float)(t >> 6) : (float)(t & 63); const float ang = pos * inv;
            rc[i] = cosf(ang); rs[i] = sinf(ang); }
        if (wg == 0 && tid < NL) { const int l = tid; float s1 = 0.f, s2 = 0.f;
            for (int k = 0; k < 64; ++k) { s1 += a.in[I_LQ1][l * 64 + k] * a.in[I_LK1][l * 64 + k]; s2 += a.in[I_LQ2][l * 64 + k] * a.in[I_LK2][l * 64 + k]; }
            ((float*)(a.ws + WS_LAM))[l] = expf(s1) - expf(s2) + (0.8f - 0.6f * expf(-0.3f * (float)l)); }
    }
    for (int u = wg; u < NL * 64; u += G) {
        const int l = u >> 6, k0 = (u & 63) * 16;
        __syncthreads();
        for (int i = tid; i < 16 * 256; i += 512) wt[i] = a.in[I_WIN][((size_t)l * D + k0 + (i >> 8)) * 3072 + 2816 + (i & 255)];
        __syncthreads();
        const int o = tid, ty = o >> 8, g = (o >> 6) & 3, k2 = o & 63;
        float acc[16];
#pragma unroll
        for (int kr = 0; kr < 16; ++kr) acc[kr] = 0.f;
        for (int c = 0; c < 64; ++c) { const int m = ((k2 * c) & 63) * 32; const float tw = ty == 0 ? ct[m] : ct[(m + 1536) & 2047];
#pragma unroll
            for (int kr = 0; kr < 16; ++kr) acc[kr] += wt[kr * 256 + g * 64 + c] * tw; }
        bf16* dst = (bf16*)(a.ws + WS_W + (size_t)l * WL_STRIDE + WL_IN) + (size_t)(2816 + o) * D + k0;
        u32x4 w0, w1;
        w0.x = cvt_pk_bf16(acc[0] * 0.125f, acc[1] * 0.125f); w0.y = cvt_pk_bf16(acc[2] * 0.125f, acc[3] * 0.125f); w0.z = cvt_pk_bf16(acc[4] * 0.125f, acc[5] * 0.125f); w0.w = cvt_pk_bf16(acc[6] * 0.125f, acc[7] * 0.125f);
        w1.x = cvt_pk_bf16(acc[8] * 0.125f, acc[9] * 0.125f); w1.y = cvt_pk_bf16(acc[10] * 0.125f, acc[11] * 0.125f); w1.z = cvt_pk_bf16(acc[12] * 0.125f, acc[13] * 0.125f); w1.w = cvt_pk_bf16(acc[14] * 0.125f, acc[15] * 0.125f);
        *(u32x4*)dst = w0; *(u32x4*)(dst + 8) = w1;
    }
    __syncthreads();
}

constexpr int LDS_BYTES = 147456, MISC_OFF = 131072 + 320;
constexpr int NPH = 3 + NL * 10;
__global__ void __launch_bounds__(512, 2) fwd_kernel(Args a_unused) {
    extern __shared__ __attribute__((aligned(16))) unsigned char lds_raw[];
    LAS unsigned char* lds = (LAS unsigned char*)lds_raw;
    const int tid = threadIdx.x, G = gridDim.x, wg = blockIdx.x, wv = __builtin_amdgcn_readfirstlane(threadIdx.x >> 6);
    volatile LAS unsigned* MISC = (volatile LAS unsigned*)(lds + MISC_OFF);
    if (tid < 32) MISC[tid] = 0u;
    __syncthreads();
    XcdBarrier bar; bar.bar = nullptr; bar.x = 0; bar.st = nullptr;
    int lo, hi;
    { const Args& a = fresh_args(); unsigned* barw = (unsigned*)(a.ws + WS_CTL) + CW_BAR; bar.bar = barw; lo = a.ph_lo; hi = a.ph_hi;
      if (MK_N_LAUNCHES == 1) bar = xcd_barrier_post(barw, MISC + 8); }
#ifndef PHASE_MASK
#define PHASE_MASK 0xFFFFu
#endif
#define PM(j) (((PHASE_MASK) >> (j)) & 1)
#define IN(k) (lo <= (k) && (k) < hi)
#define SEAM(k) do { if (MK_N_LAUNCHES == 1 && IN((k) + 1)) { XcdBarrier b2_ = bar; asm volatile("" : "+s"(b2_.bar)); xcd_barrier(b2_, wv); } } while (0)
#ifndef MIX_MASK
#define MIX_MASK 7
#endif
#define WSP(T, off) ((T*)(a.ws + (off)))
#define WLP(off) ((const bf16*)(a.ws + WS_W + (size_t)l * WL_STRIDE + (off)))

    if (PM(10) && IN(0)) { const Args& a = fresh_args(); ph_ada(a, lds, G, wg, wv); __syncthreads(); ph_weights(a, lds, G, wg, wv); SEAM(0); }
    if (PM(11) && IN(1)) { const Args& a = fresh_args(); ph_ln<0>(a, 0, false, lds, G, wg, wv); SEAM(1); }
#pragma unroll 1
    for (int l = 0; l < NL; ++l) {
        const bool last = (l == NL - 1); const int pb = 3 + l * 10; const int npan = last ? 64 : 72;
        if (PM(0) && IN(pb + 0)) {
            const Args& a = fresh_args();
            SchedIn S{WSP(const bf16, WS_HL), WLP(WL_IN), G, wg, last};
            EpiIn E{WSP(bf16, WS_R1), WSP(bf16, WS_ZT), WSP(const float, WS_ROPE), WSP(const float, WS_ROPE) + 2048 * 32};
            gemm_phase(lds, S, E, wv); SEAM(pb + 0);
        }
        if (PM(1) && IN(pb + 1)) {
            if (MIX_MASK & 1) {
                const Args& a = fresh_args();
                const float lam = WSP(const float, WS_LAM)[l]; const float osc = 1.0f - (0.8f - 0.6f * expf(-0.3f * (float)l));
                const float* subg = a.in[I_SUBLN] + l * 128;
                const bf16* Zb = WSP(const bf16, WS_R1); float* O1b = WSP(float, WS_R2); bf16* Yb = WSP(bf16, WS_Y);
                const int nun = last ? 256 : 288;
                for (int u = wg; u < nun; u += G) {
                    int qrow0, crow0, lrow0, nt, h;
                    if (u < 256) { const int b = u >> 5; h = (u >> 3) & 3; qrow0 = b * 2048 + (u & 7) * 256; crow0 = RL + b * 256; lrow0 = b * 2048; nt = 36; }
                    else { const int q = u - 256, b = q >> 2; h = q & 3; qrow0 = RL + b * 256; crow0 = qrow0; lrow0 = 0; nt = 4; }
                    attn_pass<0>(Zb, O1b, qrow0, crow0, lrow0, 4, nt, h, (LAS char*)lds, wv);
                    attn_pass<1>(Zb, O1b, qrow0, crow0, lrow0, 4, nt, h, (LAS char*)lds, wv);
                    attn_combine(O1b, Yb, qrow0, h, lam, osc, subg, wv);
                }
                __syncthreads();
            }
            if (MIX_MASK & 2) { const Args& a = fresh_args(); SchedFourier S{WSP(const bf16, WS_FLAT), WSP(const bf16, WS_FCTX), WSP(const bf16, WS_ZT), G, (wg + 128) % G, last}; EpiStoreBf16 E{WSP(bf16, WS_Y), YC}; gemm_phase(lds, S, E, wv); }
            __syncthreads();
            if (MIX_MASK & 4) { const Args& a = fresh_args(); ph_prep(a, l, last, lds, G, (wg + 64) % G, wv); }
            SEAM(pb + 1);
        }
        if (PM(2) && IN(pb + 2)) { const Args& a = fresh_args(); SchedP S{WSP(const bf16, WS_Y), WLP(WL_P), G, wg, npan}; EpiStoreBf16 E{WSP(bf16, WS_R2), PC}; gemm_phase(lds, S, E, wv); SEAM(pb + 2); }
        if (PM(3) && IN(pb + 3)) { const Args& a = fresh_args(); SchedGate S{WSP(const bf16, WS_HL), WLP(WL_G), G, wg, npan}; EpiGate E{WSP(const bf16, WS_R2), WSP(bf16, WS_R1), a.in[I_BGATE] + l * 4096}; gemm_phase(lds, S, E, wv); SEAM(pb + 3); }
        if (PM(4) && IN(pb + 4)) { const Args& a = fresh_args(); SchedWo S{WSP(const bf16, WS_R1), WLP(WL_O), G, wg, npan}; EpiF32 E{WSP(float, WS_R2), D}; gemm_phase(lds, S, E, wv); SEAM(pb + 4); }
        if (PM(5) && IN(pb + 5)) { const Args& a = fresh_args(); ph_ln<1>(a, l, last, lds, G, wg, wv); SEAM(pb + 5); }
        if (PM(6) && IN(pb + 6)) { const Args& a = fresh_args(); ph_topk(a, last, lds, G, wg, wv); SEAM(pb + 6); }
        if (PM(7) && IN(pb + 7)) { const Args& a = fresh_args(); SchedE1 S{WSP(const bf16, WS_HL), WLP(WL_GU), WSP(const int, WS_IDX), G, wg, last ? 128 : 144}; EpiSwiglu E{WSP(bf16, WS_R1)}; gemm_phase(lds, S, E, wv); SEAM(pb + 7); }
        if (PM(8) && IN(pb + 8)) { const Args& a = fresh_args(); SchedE2 S{WSP(const bf16, WS_R1), WLP(WL_D), G, wg, last ? 128 : 144}; EpiDown E{WSP(bf16, WS_R2 + 72 * MiB), WSP(const float, WS_GV)}; gemm_phase(lds, S, E, wv); SEAM(pb + 8); }
        if (PM(9) && IN(pb + 9)) { const Args& a = fresh_args(); ph_ln<2>(a, l, last, lds, G, wg, wv); if (!last) SEAM(pb + 9); }
    }
#undef IN
#undef SEAM
}

extern "C" void kernel_launch(void* const* d_in, const int* in_sizes, int n_in, void* d_out, int out_size, void* d_ws, size_t ws_size, hipStream_t stream) {
    static int grid = 0;
    if (grid == 0) {
        if (n_in != 32 || in_sizes[0] != RL * D || out_size != RL * D || ws_size < WS_END) { fprintf(stderr, "kernel_launch: unexpected shapes (n_in %d, in0 %d, out %d, ws %zu < %zu)\n", n_in, n_in > 0 ? in_sizes[0] : -1, out_size, ws_size, (size_t)WS_END); grid = -1; return; }
        int dev = 0, cus = 0, per_cu = 0;
        if (hipGetDevice(&dev) != hipSuccess || hipDeviceGetAttribute(&cus, hipDeviceAttributeMultiprocessorCount, dev) != hipSuccess) { grid = -1; return; }
        if (hipFuncSetAttribute((const void*)fwd_kernel, hipFuncAttributeMaxDynamicSharedMemorySize, LDS_BYTES) != hipSuccess) { fprintf(stderr, "kernel_launch: hipFuncSetAttribute failed\n"); grid = -1; return; }
        if (hipOccupancyMaxActiveBlocksPerMultiprocessor(&per_cu, (const void*)fwd_kernel, 512, LDS_BYTES) != hipSuccess || per_cu < 1) fprintf(stderr, "kernel_launch: occupancy query says %d\n", per_cu);
        (void)hipGetLastError();
        grid = cus;
    }
    if (grid < 0) return;
    if (hipMemsetAsync((char*)d_ws + WS_CTL, 0, CTL_ZERO_BYTES, stream) != hipSuccess) return;
    Args a{};
    for (int i = 0; i < 32; ++i) a.in[i] = (const float*)d_in[i];
    a.out = (float*)d_out; a.ws = (unsigned char*)d_ws;
#if MK_N_LAUNCHES == 1
    a.ph_lo = 0; a.ph_hi = NPH;
    hipLaunchKernelGGL(fwd_kernel, dim3(grid), dim3(512), LDS_BYTES, stream, a);
#else
    for (int p = 0; p < NPH; ++p) { if (p == 2) continue; a.ph_lo = p; a.ph_hi = p + 1; hipLaunchKernelGGL(fwd_kernel, dim3(grid), dim3(512), LDS_BYTES, stream, a); }
#endif
    const hipError_t le = hipPeekAtLastError();
    if (le != hipSuccess) fprintf(stderr, "kernel_launch: launch failed: %s\n", hipGetErrorName(le));
}
```

```cpp
#include <hip/hip_runtime.h>
#include <cstdio>
#include <cstdint>

#ifndef MK_N_LAUNCHES
#define MK_N_LAUNCHES 1
#endif
#ifndef GEMM_FAST
#define GEMM_FAST 0
#endif

#define GAS __attribute__((address_space(1)))
#define LAS __attribute__((address_space(3)))
typedef unsigned short bf16;
typedef short bf16x8 __attribute__((ext_vector_type(8)));
typedef short s16x4 __attribute__((ext_vector_type(4)));
typedef float f32x4 __attribute__((ext_vector_type(4)));
typedef float f32x2 __attribute__((ext_vector_type(2)));
typedef float f32x16 __attribute__((ext_vector_type(16)));
typedef unsigned u32x4 __attribute__((ext_vector_type(4)));
typedef unsigned u32x2 __attribute__((ext_vector_type(2)));

constexpr int D = 1024, NB = 8, SEQ = 2048, CTXL = 256, NL = 4;
constexpr int RL = NB * SEQ, RC = NB * CTXL, R = RL + RC;
constexpr int ZC = 3328, YC = 1280, PC = 4096, M2C = 2048;
constexpr int NE = 16, CAPL = 256, CAPC = 32;
constexpr int HROWS = NE * NB * CAPL + NE * NB * CAPC;
constexpr float LN_EPS = 1e-5f, RMS_EPS = 1e-5f, DN_ALPHA = 1.6817928305074290f;

constexpr size_t MiB = 1u << 20;
constexpr size_t WS_CTL = 0, CTL_ZERO_BYTES = 1 * MiB;
constexpr size_t WS_ADA = 1 * MiB;
constexpr size_t WS_LAM = 2 * MiB;
constexpr size_t WS_WSPB = 2 * MiB + 4096;
constexpr size_t WS_ROPE = 3 * MiB;
constexpr size_t WS_FCTX = 4 * MiB;
constexpr size_t WS_AFF = 5 * MiB;
constexpr size_t WS_IDX = 7 * MiB;
constexpr size_t WS_GV = 7 * MiB + 512 * 1024;
constexpr size_t WS_INV = 8 * MiB;
constexpr size_t WS_FLAT = 10 * MiB;
constexpr size_t WS_ZT = 26 * MiB;
constexpr size_t WS_X = 44 * MiB;
constexpr size_t WS_HL = 116 * MiB;
constexpr size_t WS_Y = 152 * MiB;
constexpr size_t WS_R1 = 197 * MiB;
constexpr size_t WS_R2 = 314 * MiB;
constexpr size_t WS_W = 458 * MiB;
constexpr size_t WL_IN = 0, WL_G = 7 * MiB, WL_P = 15 * MiB, WL_O = 19 * MiB, WL_GU = 23 * MiB, WL_D = 87 * MiB, WL_STRIDE = 119 * MiB;
constexpr size_t WS_END = WS_W + 4 * WL_STRIDE;
constexpr int CW_BAR = 4096;

__device__ __forceinline__ unsigned cvt_pk_bf16(float lo, float hi) { unsigned r; asm volatile("v_cvt_pk_bf16_f32 %0, %1, %2" : "=v"(r) : "v"(lo), "v"(hi)); return r; }
__device__ __forceinline__ float bf2f(unsigned short b) { return __uint_as_float((unsigned)b << 16); }
__device__ __forceinline__ float bflo(unsigned w) { return __uint_as_float(w << 16); }
__device__ __forceinline__ float bfhi(unsigned w) { return __uint_as_float(w & 0xffff0000u); }
__device__ __forceinline__ unsigned short f2bf(float f) { return (unsigned short)(cvt_pk_bf16(f, 0.f) & 0xffffu); }
__device__ __forceinline__ float wave_sum(float v) {
#pragma unroll
    for (int o = 1; o < 64; o <<= 1) v += __shfl_xor(v, o);
    return v;
}
__device__ __forceinline__ int wave_sum_i(int v) {
#pragma unroll
    for (int o = 1; o < 64; o <<= 1) v += __shfl_xor(v, o);
    return v;
}
__device__ __forceinline__ float sigmoid_f(float x) { return __builtin_amdgcn_rcpf(1.f + __expf(-x)); }
__device__ __forceinline__ float gelu_tanh(float x) { const float y = 0.7978845608028654f * (x + 0.044715f * x * x * x); return x * sigmoid_f(2.f * y); }
#define LDS_WAIT() asm volatile("s_waitcnt lgkmcnt(0)" ::: "memory")
#define VM_WAIT() asm volatile("s_waitcnt vmcnt(0)" ::: "memory")

__device__ __forceinline__ int tid_opaque(int wv) { unsigned z = 0u; asm volatile("" : "+v"(z)); return wv * 64 + (int)__builtin_amdgcn_mbcnt_hi(~0u, __builtin_amdgcn_mbcnt_lo(~0u, z)); }
#define XB_TMO      128
#define XB_XCNT(j)  (256  + 64 * (j))
#define XB_XSUB(j)  (1280 + 64 * (j))
#define XB_XGEN(j)  (2304 + 64 * (j))
#define XB_TOP      3328
#define XB_TOPGEN   3392
#define XCD_BAR_WORDS 3456
#define XB_SPIN_CAP (1u << 22)
__device__ __forceinline__ unsigned xb_ld(unsigned* p)              { return __hip_atomic_load(p, __ATOMIC_RELAXED, __HIP_MEMORY_SCOPE_AGENT); }
__device__ __forceinline__ unsigned xb_add(unsigned* p, unsigned v) { return __hip_atomic_fetch_add(p, v, __ATOMIC_RELAXED, __HIP_MEMORY_SCOPE_AGENT); }
__device__ __forceinline__ unsigned xb_xcc_id() { return (unsigned)__builtin_amdgcn_s_getreg((3 << 11) | 20) & 0xFu; }
#define XB_SPIN(cond, bar) do { unsigned _sp = 0; while (cond) { __builtin_amdgcn_s_sleep(1); \
    if ((++_sp & 255u) == 0u) { if (xb_ld(&(bar)[XB_TMO])) break; if (_sp > XB_SPIN_CAP) { atomicAdd(&(bar)[XB_TMO], 1u); break; } } } } while (0)
struct XcdBarrier { unsigned* bar; unsigned x; volatile LAS unsigned* st; };
__device__ __forceinline__ XcdBarrier xcd_barrier_post(unsigned* bar, volatile LAS unsigned* st) {
    XcdBarrier b; b.bar = bar; b.x = xb_xcc_id(); b.st = st;
    if (threadIdx.x == 0) (void)xb_add(&bar[XB_XCNT(b.x)], 1u);
    return b;
}
__device__ __forceinline__ void xcd_barrier_complete(unsigned* bar, unsigned x, unsigned& nloc, unsigned& nx) {
    const unsigned G = gridDim.x * gridDim.y * gridDim.z;
    unsigned sum, cnt, mine, sp = 0u;
    for (;;) {
        sum = 0u; cnt = 0u; mine = 0u;
#pragma unroll
        for (unsigned j = 0; j < 16; ++j) { const unsigned c = xb_ld(&bar[XB_XCNT(j)]); sum += c; cnt += (c > 0u) ? 1u : 0u; mine = (j == x) ? c : mine; }
        if (sum == G) break;
        __builtin_amdgcn_s_sleep(1);
        if ((++sp & 255u) == 0u) { if (xb_ld(&bar[XB_TMO])) break; if (sp > XB_SPIN_CAP) { atomicAdd(&bar[XB_TMO], 1u); break; } }
    }
    nloc = mine > 0u ? mine : 1u; nx = cnt > 0u ? cnt : 1u;
}
__device__ __forceinline__ void xcd_barrier(const XcdBarrier& b, int wv) {
    asm volatile("s_waitcnt vmcnt(0)" ::: "memory");
    __syncthreads();
    if (tid_opaque(wv) == 0) {
        unsigned* bar = b.bar;
        __builtin_amdgcn_s_waitcnt(0);
        unsigned nloc = b.st[0], nx = b.st[1];
        if (nloc == 0u) { xcd_barrier_complete(bar, b.x, nloc, nx); b.st[0] = nloc; b.st[1] = nx; }
        const unsigned old = xb_add(&bar[XB_XSUB(b.x)], 1u);
        const unsigned gen = old / nloc;
        if (old + 1u == (gen + 1u) * nloc) {
            __builtin_amdgcn_fence(__ATOMIC_RELEASE, "agent");
            asm volatile("s_waitcnt vmcnt(0)" ::: "memory");
            const unsigned og = xb_add(&bar[XB_TOP], 1u);
            const unsigned tg = og / nx;
            if (og + 1u == (tg + 1u) * nx) xb_add(&bar[XB_TOPGEN], 1u);
            else XB_SPIN(xb_ld(&bar[XB_TOPGEN]) == tg, bar);
            __builtin_amdgcn_fence(__ATOMIC_ACQUIRE, "agent");
            xb_add(&bar[XB_XGEN(b.x)], 1u);
            asm volatile("s_waitcnt vmcnt(0)" ::: "memory");
        } else {
            XB_SPIN(xb_ld(&bar[XB_XGEN(b.x)]) == gen, bar);
            __builtin_amdgcn_fence(__ATOMIC_ACQUIRE, "agent");
            asm volatile("s_waitcnt vmcnt(0)" ::: "memory");
        }
    }
    __syncthreads();
}

struct Args { const float* in[32]; float* out; unsigned char* ws; int ph_lo, ph_hi; };
enum { I_X = 0, I_C, I_CTX, I_CCTX, I_WADA, I_BADA, I_WIN, I_WGATE, I_BGATE, I_SGUG, I_SGUB, I_WSP, I_BSP, I_CONVW, I_LQ1, I_LK1, I_LQ2, I_LK2, I_SUBLN,
       I_WPA, I_WPB, I_WPC, I_WPD, I_WO, I_LN1G, I_LN1B, I_WROUTER, I_WEG, I_WEU, I_WED, I_LN2G, I_LN2B };

__device__ __forceinline__ const Args& fresh_args() { auto p = (const __attribute__((address_space(4))) Args*)__builtin_amdgcn_kernarg_segment_ptr(); asm volatile("" : "+s"(p)); return *(const Args*)p; }
struct Unit { const bf16* A; const bf16* B; const int* gidx; int lda, ldb, K, pm, pn, aux; };
__device__ __forceinline__ int perm32(int rho) { const int n = rho >> 4, i = rho & 15; return 8 * (i >> 2) + 4 * n + (i & 3); }

template <class Epi, class Sched>
__device__ __forceinline__ void gemm_phase_simple(LAS unsigned char* lds, const Sched& S, const Epi& E, int wv) {
    const int tid = tid_opaque(wv), wid = __builtin_amdgcn_readfirstlane(tid >> 6), lane = tid & 63, wr = wid >> 2, wc = wid & 3, fr = lane & 15, fq = lane >> 4;
    Unit u;
    for (int i = 0; S.next(i, u); ++i) {
        f32x4 acc[2][2][4][2];
#pragma unroll
        for (int a = 0; a < 2; ++a)
#pragma unroll
            for (int b = 0; b < 2; ++b)
#pragma unroll
                for (int m = 0; m < 4; ++m)
#pragma unroll
                    for (int n = 0; n < 2; ++n) acc[a][b][m][n] = (f32x4){0.f, 0.f, 0.f, 0.f};
        unsigned ao[2][4], bo[2][2];
#pragma unroll
        for (int ai = 0; ai < 2; ++ai)
#pragma unroll
            for (int m = 0; m < 4; ++m) { const int r = ai * 128 + wr * 64 + m * 16 + fr; const unsigned gr = u.gidx ? (unsigned)u.gidx[r] : (unsigned)r; ao[ai][m] = gr * (unsigned)u.lda + fq * 8; }
#pragma unroll
        for (int bj = 0; bj < 2; ++bj)
#pragma unroll
            for (int n = 0; n < 2; ++n) { const int slot = n * 16 + fr; const int rr = Epi::PERM ? perm32(slot) : slot; bo[bj][n] = (unsigned)(bj * 128 + wc * 32 + rr) * (unsigned)u.ldb + fq * 8; }
        for (int k0 = 0; k0 < u.K; k0 += 64) {
#pragma unroll
            for (int ai = 0; ai < 2; ++ai) {
                bf16x8 At[4][2];
#pragma unroll
                for (int m = 0; m < 4; ++m)
#pragma unroll
                    for (int k = 0; k < 2; ++k) At[m][k] = *(const bf16x8*)(u.A + k0 + k * 32 + ao[ai][m]);
#pragma unroll
                for (int bj = 0; bj < 2; ++bj) {
                    bf16x8 Bf[2][2];
#pragma unroll
                    for (int n = 0; n < 2; ++n)
#pragma unroll
                        for (int k = 0; k < 2; ++k) Bf[n][k] = *(const bf16x8*)(u.B + k0 + k * 32 + bo[bj][n]);
#pragma unroll
                    for (int m = 0; m < 4; ++m)
#pragma unroll
                        for (int n = 0; n < 2; ++n)
#pragma unroll
                            for (int k = 0; k < 2; ++k) acc[ai][bj][m][n] = __builtin_amdgcn_mfma_f32_16x16x32_bf16(Bf[n][k], At[m][k], acc[ai][bj][m][n], 0, 0, 0);
                }
            }
        }
        E(acc, u, wr, wc, fr, fq);
    }
}


constexpr int HTB = 128 * 64 * 2, GATHER_OFF = 131072 + 1024;
__device__ __forceinline__ int lds_byte(int r, int c) { const int st = (r >> 4) * 2 + (c >> 5), rr = r & 15, cc = c & 31, ob = rr * 64 + cc * 2; return st * 1024 + (ob ^ (((ob >> 9) & 1) << 5)); }
__device__ __forceinline__ void stage_rc(int b, int& Rr, int& Cc) { const int st = b / 1024, sb = b % 1024, swz = sb ^ (((sb >> 9) & 1) << 5); Rr = (st >> 1) * 16 + swz / 64; Cc = (st & 1) * 32 + (swz % 64) / 2; }
template <class Epi, class Sched>
__device__ __forceinline__ void gemm_phase(LAS unsigned char* lds, const Sched& S, const Epi& E, int wv) {
    const int tid = tid_opaque(wv), wid = __builtin_amdgcn_readfirstlane(tid >> 6), lane = tid & 63, wr = wid >> 2, wc = wid & 3, fr = lane & 15, fq = lane >> 4;
    Unit cur, nxt; int ui = 0;
    if (!S.next(0, cur)) return;
    if (Sched::GATHER) {
        LAS int* gl = (LAS int*)(lds + GATHER_OFF);
        Unit t_;
        for (int i = 0; S.next(i, t_); ++i) if (tid < 256) gl[i * 256 + tid] = t_.gidx[tid];
        __syncthreads();
    }
    int sR[2], sC[2], sRb[2];
#pragma unroll
    for (int i = 0; i < 2; ++i) { int Rr, Cc; stage_rc(tid * 16 + i * 8192, Rr, Cc); sR[i] = Rr; sC[i] = Cc; sRb[i] = Epi::PERM ? ((Rr & ~31) + perm32(Rr & 31)) : Rr; }
    const unsigned ldsw = (unsigned)wid * 1024u;
    const int aoff = lds_byte(wr * 64 + fr, fq * 8), boff = lds_byte(wc * 32 + fr, fq * 8);
    unsigned vA[2][2], vB[2]; size_t hB;
#define G_OFFS(u_, ui_) do { _Pragma("unroll") for (int h_ = 0; h_ < 2; ++h_) _Pragma("unroll") for (int i_ = 0; i_ < 2; ++i_) { const int r_ = h_ * 128 + sR[i_]; \
        const unsigned gr_ = Sched::GATHER ? (unsigned)((LAS int*)(lds + GATHER_OFF))[(ui_) * 256 + r_] : (unsigned)r_; vA[h_][i_] = (gr_ * (unsigned)(u_).lda + (unsigned)sC[i_]) * 2u; } \
        _Pragma("unroll") for (int i_ = 0; i_ < 2; ++i_) vB[i_] = ((unsigned)sRb[i_] * (unsigned)(u_).ldb + (unsigned)sC[i_]) * 2u; hB = (size_t)(u_).ldb * 256; } while (0)
#define G_SA(b, h) (((b) * 2 + (h)) * HTB)
#define G_SB(b, h) ((4 + (b) * 2 + (h)) * HTB)
#define G_STAGE(bufoff, gbase, voff) do { _Pragma("unroll") for (int _i = 0; _i < 2; ++_i) \
        __builtin_amdgcn_global_load_lds((const unsigned*)((const char*)(gbase) + (voff)[_i]), (LAS unsigned*)(lds + (bufoff) + ldsw + _i * 8192), 16, 0, 0); } while (0)
#define G_LDA(dst, b, h) do { _Pragma("unroll") for (int m = 0; m < 4; ++m) _Pragma("unroll") for (int k = 0; k < 2; ++k) dst[m][k] = *(const LAS bf16x8*)(lds + G_SA(b, h) + aoff + m * 2048 + k * 1024); } while (0)
#define G_LDB(dst, b, h) do { _Pragma("unroll") for (int n = 0; n < 2; ++n) _Pragma("unroll") for (int k = 0; k < 2; ++k) dst[n][k] = *(const LAS bf16x8*)(lds + G_SB(b, h) + boff + n * 2048 + k * 1024); } while (0)
#define G_MMA(ai, bj, At_, Bt_) do { __builtin_amdgcn_s_setprio(1); _Pragma("unroll") for (int m = 0; m < 4; ++m) _Pragma("unroll") for (int n = 0; n < 2; ++n) _Pragma("unroll") for (int k = 0; k < 2; ++k) \
        acc[ai][bj][m][n] = __builtin_amdgcn_mfma_f32_16x16x32_bf16(Bt_[n][k], At_[m][k], acc[ai][bj][m][n], 0, 0, 0); __builtin_amdgcn_s_setprio(0); } while (0)
#define G_WAIT_V(n) asm volatile("s_waitcnt vmcnt(" #n ")" ::: "memory")
#define G_WAIT_L(n) asm volatile("s_waitcnt lgkmcnt(" #n ")" ::: "memory")
#define G_BAR __builtin_amdgcn_s_barrier()
#define G_SCHED __builtin_amdgcn_sched_barrier(0)
    f32x4 acc[2][2][4][2];
#pragma unroll
    for (int a = 0; a < 2; ++a)
#pragma unroll
        for (int b = 0; b < 2; ++b)
#pragma unroll
            for (int m = 0; m < 4; ++m)
#pragma unroll
                for (int n = 0; n < 2; ++n) acc[a][b][m][n] = (f32x4){0.f, 0.f, 0.f, 0.f};
    bf16x8 At[4][2], B0[2][2], B1[2][2];
    const char* cA = (const char*)cur.A; const char* cB = (const char*)cur.B;
    const size_t kstep = 128;
    G_OFFS(cur, 0);
    G_STAGE(G_SB(0, 0), cB, vB); G_STAGE(G_SB(0, 1), cB + hB, vB); G_STAGE(G_SA(0, 0), cA, vA[0]); G_STAGE(G_SA(0, 1), cA, vA[1]);
    if (wr == 1) G_BAR;
    G_WAIT_V(2); G_BAR;
    G_STAGE(G_SB(1, 0), cB + kstep, vB); G_STAGE(G_SA(1, 0), cA + kstep, vA[0]); G_STAGE(G_SB(1, 1), cB + hB + kstep, vB);
    G_WAIT_V(6); G_BAR;
    for (;;) {
        const bool has_next = S.next(ui + 1, nxt);
        const char* nA = has_next ? (const char*)nxt.A : cA; const char* nB = has_next ? (const char*)nxt.B : cB;
        const int nt = cur.K >> 6;
        for (int t = 0; t < nt; t += 2) {
            const bool last = (t == nt - 2);
            const char* a1 = cA + (size_t)(t + 1) * kstep;
            const char* a2 = last ? nA : cA + (size_t)(t + 2) * kstep; const char* b2 = last ? nB : cB + (size_t)(t + 2) * kstep;
            const char* a3 = a2 + kstep; const char* b3 = b2 + kstep;
            G_LDB(B0, 0, 0); G_LDB(B1, 0, 1); G_SCHED; G_LDA(At, 0, 0); G_STAGE(G_SA(1, 1), a1, vA[1]);
            if (last && has_next) G_OFFS(nxt, ui + 1);
            G_WAIT_V(8); G_WAIT_L(0); G_BAR; G_MMA(0, 0, At, B0); G_MMA(0, 1, At, B1); G_BAR; G_SCHED;
            G_LDA(At, 0, 1); G_STAGE(G_SB(0, 0), b2, vB); G_STAGE(G_SB(0, 1), b2 + hB, vB); G_STAGE(G_SA(0, 0), a2, vA[0]);
            G_WAIT_V(8); G_WAIT_L(0); G_BAR; G_MMA(1, 0, At, B0); G_MMA(1, 1, At, B1); G_BAR; G_SCHED;
            G_LDB(B0, 1, 0); G_LDB(B1, 1, 1); G_SCHED; G_LDA(At, 1, 0); G_STAGE(G_SA(0, 1), a2, vA[1]);
            G_WAIT_V(8); G_WAIT_L(0); G_BAR; G_MMA(0, 0, At, B0); G_MMA(0, 1, At, B1); G_BAR; G_SCHED;
            G_LDA(At, 1, 1); G_STAGE(G_SB(1, 0), b3, vB); G_STAGE(G_SB(1, 1), b3 + hB, vB); G_STAGE(G_SA(1, 0), a3, vA[0]);
            G_WAIT_V(8); G_WAIT_L(0); G_BAR; G_MMA(1, 0, At, B0); G_MMA(1, 1, At, B1); G_BAR; G_SCHED;
        }
        if (wr == 0) G_BAR;
        E(acc, cur, wr, wc, fr, fq);
        if (!has_next) break;
#pragma unroll
        for (int a = 0; a < 2; ++a)
#pragma unroll
            for (int b = 0; b < 2; ++b)
#pragma unroll
                for (int m = 0; m < 4; ++m)
#pragma unroll
                    for (int n = 0; n < 2; ++n) acc[a][b][m][n] = (f32x4){0.f, 0.f, 0.f, 0.f};
        cur = nxt; cA = nA; cB = nB; ++ui;
        if (wr == 1) G_BAR;
    }
    G_WAIT_V(0);
    G_BAR;
#undef G_OFFS
#undef G_SA
#undef G_SB
#undef G_STAGE
#undef G_LDA
#undef G_LDB
#undef G_MMA
#undef G_WAIT_V
#undef G_WAIT_L
#undef G_BAR
#undef G_SCHED
}

#define EPI_ROWS_BEGIN _Pragma("unroll") for (int ai = 0; ai < 2; ++ai) _Pragma("unroll") for (int m = 0; m < 4; ++m) { const int rl = ai * 128 + wr * 64 + m * 16 + fr;
#define EPI_ROWS_END }
__device__ __forceinline__ u32x4 pack8(const f32x4 a, const f32x4 b) { u32x4 w; w.x = cvt_pk_bf16(a[0], a[1]); w.y = cvt_pk_bf16(a[2], a[3]); w.z = cvt_pk_bf16(b[0], b[1]); w.w = cvt_pk_bf16(b[2], b[3]); return w; }
__device__ __forceinline__ void unpack8(const u32x4 w, float (&f)[8]) { f[0] = bflo(w.x); f[1] = bfhi(w.x); f[2] = bflo(w.y); f[3] = bfhi(w.y); f[4] = bflo(w.z); f[5] = bfhi(w.z); f[6] = bflo(w.w); f[7] = bfhi(w.w); }

struct EpiIn {
    static constexpr bool PERM = true;
    bf16* Z; bf16* ZT; const float* ropec; const float* ropes;
    __device__ __forceinline__ void operator()(const f32x4 (&acc)[2][2][4][2], const Unit& u, int wr, int wc, int fr, int fq) const {
        const int pn = u.pn; const bool lat = u.pm < 64;
        EPI_ROWS_BEGIN
            const int row = u.pm * 256 + rl;
#pragma unroll
            for (int bj = 0; bj < 2; ++bj) {
                const int col0 = pn * 256 + bj * 128 + wc * 32 + 8 * fq;
                f32x4 v0 = acc[ai][bj][m][0], v1 = acc[ai][bj][m][1];
                if (pn < 2) {
#pragma unroll
                    for (int j = 0; j < 4; ++j) { v0[j] = gelu_tanh(v0[j]); v1[j] = gelu_tanh(v1[j]); }
                } else if (pn >= 5 && pn <= 8 && lat) {
                    const int t = row & 2047, p0 = (col0 & 63) >> 1;
                    const f32x4 cs = *(const f32x4*)(ropec + t * 32 + p0), sn = *(const f32x4*)(ropes + t * 32 + p0);
                    const f32x4 a = v0, b = v1;
                    v0[0] = a[0] * cs[0] - a[1] * sn[0]; v0[1] = a[0] * sn[0] + a[1] * cs[0];
                    v0[2] = a[2] * cs[1] - a[3] * sn[1]; v0[3] = a[2] * sn[1] + a[3] * cs[1];
                    v1[0] = b[0] * cs[2] - b[1] * sn[2]; v1[1] = b[0] * sn[2] + b[1] * cs[2];
                    v1[2] = b[2] * cs[3] - b[3] * sn[3]; v1[3] = b[2] * sn[3] + b[3] * cs[3];
                }
                if (pn < 11) {
                    *(u32x4*)(Z + (size_t)row * ZC + col0) = pack8(v0, v1);
                } else {
                    const int cc = col0 - pn * 256;
#pragma unroll
                    for (int j = 0; j < 8; ++j) {
                        const float val = j < 4 ? v0[j & 3] : v1[j & 3];
                        size_t o;
                        if (lat) { const int b = row >> 11, n = row & 2047; o = ((size_t)(b * 256 + cc + j)) * 4096 + (pn == 12 ? 2048 : 0) + n; }
                        else { const int rc = row - RL, b = rc >> 8, n = rc & 255; o = (size_t)8 * 256 * 4096 + ((size_t)(b * 256 + cc + j)) * 512 + (pn == 12 ? 256 : 0) + n; }
                        ZT[o] = f2bf(val);
                    }
                }
            }
        EPI_ROWS_END
    }
};
struct EpiStoreBf16 {
    static constexpr bool PERM = true;
    bf16* O; int ldc;
    __device__ __forceinline__ void operator()(const f32x4 (&acc)[2][2][4][2], const Unit& u, int wr, int wc, int fr, int fq) const {
        EPI_ROWS_BEGIN
#pragma unroll
            for (int bj = 0; bj < 2; ++bj) { const int col0 = u.pn * 256 + bj * 128 + wc * 32 + 8 * fq;
                *(u32x4*)(O + (size_t)(u.aux + rl) * ldc + col0) = pack8(acc[ai][bj][m][0], acc[ai][bj][m][1]); }
        EPI_ROWS_END
    }
};
struct EpiGate {
    static constexpr bool PERM = true;
    const bf16* P; bf16* M2; const float* bgate;
    __device__ __forceinline__ void operator()(const f32x4 (&acc)[2][2][4][2], const Unit& u, int wr, int wc, int fr, int fq) const {
        const int p = u.pn >> 3, cb = (u.pn & 7) * 128 + wc * 32 + 8 * fq;
        float b0[8], b1[8];
        { const f32x4 x0 = *(const f32x4*)(bgate + (2 * p) * 1024 + cb), x1 = *(const f32x4*)(bgate + (2 * p) * 1024 + cb + 4), y0 = *(const f32x4*)(bgate + (2 * p + 1) * 1024 + cb), y1 = *(const f32x4*)(bgate + (2 * p + 1) * 1024 + cb + 4);
#pragma unroll
          for (int j = 0; j < 4; ++j) { b0[j] = x0[j]; b0[4 + j] = x1[j]; b1[j] = y0[j]; b1[4 + j] = y1[j]; } }
        EPI_ROWS_BEGIN
            const size_t row = (size_t)u.pm * 256 + rl;
            float p0[8], p1[8];
            unpack8(*(const u32x4*)(P + row * PC + (2 * p) * 1024 + cb), p0);
            unpack8(*(const u32x4*)(P + row * PC + (2 * p + 1) * 1024 + cb), p1);
            f32x4 o0, o1;
#pragma unroll
            for (int j = 0; j < 4; ++j) {
                o0[j] = sigmoid_f(acc[ai][0][m][0][j] + b0[j]) * p0[j] + sigmoid_f(acc[ai][1][m][0][j] + b1[j]) * p1[j];
                o1[j] = sigmoid_f(acc[ai][0][m][1][j] + b0[4 + j]) * p0[4 + j] + sigmoid_f(acc[ai][1][m][1][j] + b1[4 + j]) * p1[4 + j];
            }
            *(u32x4*)(M2 + row * M2C + p * 1024 + cb) = pack8(o0, o1);
        EPI_ROWS_END
    }
};
struct EpiF32 {
    static constexpr bool PERM = false;
    float* C; int ldc;
    __device__ __forceinline__ void operator()(const f32x4 (&acc)[2][2][4][2], const Unit& u, int wr, int wc, int fr, int fq) const {
        EPI_ROWS_BEGIN
            float* rowp = C + ((size_t)u.pm * 256 + rl) * ldc + u.pn * 256 + wc * 32 + 4 * fq;
#pragma unroll
            for (int bj = 0; bj < 2; ++bj)
#pragma unroll
                for (int n = 0; n < 2; ++n) *(f32x4*)(rowp + bj * 128 + n * 16) = acc[ai][bj][m][n];
        EPI_ROWS_END
    }
};
struct EpiSwiglu {
    static constexpr bool PERM = true;
    bf16* HID;
    __device__ __forceinline__ void operator()(const f32x4 (&acc)[2][2][4][2], const Unit& u, int wr, int wc, int fr, int fq) const {
        EPI_ROWS_BEGIN
            f32x4 o0, o1;
#pragma unroll
            for (int j = 0; j < 4; ++j) { const float g0 = acc[ai][0][m][0][j], g1 = acc[ai][0][m][1][j];
                o0[j] = g0 * sigmoid_f(g0) * acc[ai][1][m][0][j]; o1[j] = g1 * sigmoid_f(g1) * acc[ai][1][m][1][j]; }
            *(u32x4*)(HID + ((size_t)u.pm * 256 + rl) * 1024 + u.pn * 128 + wc * 32 + 8 * fq) = pack8(o0, o1);
        EPI_ROWS_END
    }
};
struct EpiDown {
    static constexpr bool PERM = true;
    bf16* YE; const float* GV;
    __device__ __forceinline__ void operator()(const f32x4 (&acc)[2][2][4][2], const Unit& u, int wr, int wc, int fr, int fq) const {
        EPI_ROWS_BEGIN
            const size_t row = (size_t)u.pm * 256 + rl; const float g = GV[row];
#pragma unroll
            for (int bj = 0; bj < 2; ++bj) *(u32x4*)(YE + row * 1024 + u.pn * 256 + bj * 128 + wc * 32 + 8 * fq) = pack8(acc[ai][bj][m][0] * g, acc[ai][bj][m][1] * g);
        EPI_ROWS_END
    }
};

struct SchedIn {
    static constexpr bool GATHER = false;
    const bf16* HL; const bf16* W; int G, c; bool last;
    __device__ __forceinline__ bool next(int i, Unit& u) const {
        const int idx = i * G + c; int pm, pn;
        if (!last) { if (idx >= 72 * 13) return false; pm = idx / 13; pn = idx % 13; }
        else { if (idx >= 64 * 13 + 32) return false; if (idx < 64 * 13) { pm = idx / 13; pn = idx % 13; } else { const int q = idx - 64 * 13; pm = 64 + (q >> 2); pn = 7 + (q & 3); } }
        u.A = HL + (size_t)pm * 256 * D; u.B = W + (size_t)pn * 256 * D; u.gidx = nullptr; u.lda = D; u.ldb = D; u.K = D; u.pm = pm; u.pn = pn; u.aux = 0; return true;
    }
};
struct SchedFourier {
    static constexpr bool GATHER = false;
    const bf16* FL; const bf16* FC; const bf16* ZT; int G, c; bool last;
    __device__ __forceinline__ bool next(int i, Unit& u) const {
        const int idx = i * G + c; if (idx >= (last ? 64 : 72)) return false;
        u.gidx = nullptr; u.pn = 4;
        if (idx < 64) { const int b = idx >> 3, pm = idx & 7; u.A = FL + (size_t)pm * 256 * 4096; u.B = ZT + (size_t)b * 256 * 4096; u.lda = 4096; u.ldb = 4096; u.K = 4096; u.pm = idx; u.aux = b * 2048 + pm * 256; }
        else { const int b = idx - 64; u.A = FC; u.B = ZT + (size_t)8 * 256 * 4096 + (size_t)b * 256 * 512; u.lda = 512; u.ldb = 512; u.K = 512; u.pm = idx; u.aux = RL + b * 256; }
        return true;
    }
};
struct SchedP {
    static constexpr bool GATHER = false;
    const bf16* Y; const bf16* W; int G, c, npan;
    __device__ __forceinline__ bool next(int i, Unit& u) const {
        const int idx = i * G + c; if (idx >= npan * 16) return false;
        const int pm = idx >> 4, q = idx & 15, br = q >> 2, pnl = q & 3;
        const int coff = br == 0 ? 0 : (br == 1 ? 256 : (br == 2 ? 512 : 1024));
        u.A = Y + (size_t)pm * 256 * YC + coff; u.B = W + ((size_t)br * 1024 + pnl * 256) * 512; u.gidx = nullptr; u.lda = YC; u.ldb = 512; u.K = br == 2 ? 512 : 256; u.pm = pm; u.pn = q; u.aux = pm * 256; return true;
    }
};
struct SchedGate {
    static constexpr bool GATHER = false;
    const bf16* HL; const bf16* W; int G, c, npan;
    __device__ __forceinline__ bool next(int i, Unit& u) const {
        const int idx = i * G + c; if (idx >= npan * 16) return false;
        const int pm = idx >> 4, tn = idx & 15;
        u.A = HL + (size_t)pm * 256 * D; u.B = W + (size_t)tn * 256 * D; u.gidx = nullptr; u.lda = D; u.ldb = D; u.K = D; u.pm = pm; u.pn = tn; u.aux = 0; return true;
    }
};
struct SchedWo {
    static constexpr bool GATHER = false;
    const bf16* M2; const bf16* W; int G, c, npan;
    __device__ __forceinline__ bool next(int i, Unit& u) const {
        const int idx = i * G + c; if (idx >= npan * 4) return false;
        const int pm = idx >> 2, pn = idx & 3;
        u.A = M2 + (size_t)pm * 256 * M2C; u.B = W + (size_t)pn * 256 * M2C; u.gidx = nullptr; u.lda = M2C; u.ldb = M2C; u.K = M2C; u.pm = pm; u.pn = pn; u.aux = 0; return true;
    }
};
struct SchedE1 {
    static constexpr bool GATHER = true;
    const bf16* HL; const bf16* W; const int* IDX; int G, c, npanel;
    __device__ __forceinline__ bool next(int i, Unit& u) const {
        const int idx = i * G + c; if (idx >= npanel * 8) return false;
        const int panel = idx >> 3, tn = idx & 7, e = panel < 128 ? (panel >> 3) : (panel - 128);
        u.A = HL; u.B = W + ((size_t)e * 2048 + tn * 256) * D; u.gidx = IDX + panel * 256; u.lda = D; u.ldb = D; u.K = D; u.pm = panel; u.pn = tn; u.aux = e; return true;
    }
};
struct SchedE2 {
    static constexpr bool GATHER = false;
    const bf16* HID; const bf16* W; int G, c, npanel;
    __device__ __forceinline__ bool next(int i, Unit& u) const {
        const int idx = i * G + c; if (idx >= npanel * 4) return false;
        const int panel = idx >> 2, pn = idx & 3, e = panel < 128 ? (panel >> 3) : (panel - 128);
        u.A = HID + (size_t)panel * 256 * 1024; u.B = W + ((size_t)e * 1024 + pn * 256) * 1024; u.gidx = nullptr; u.lda = 1024; u.ldb = 1024; u.K = 1024; u.pm = panel; u.pn = pn; u.aux = e; return true;
    }
};

constexpr int AT_SHM_V = 64 * 128 * 2, AT_SHM_K = 64 * 64 * 2;
#define KSWZ64(row, colB) ((row) * 128 + ((colB) ^ ((((row) >> 1) & 7) << 4)))
#define SBAR() __builtin_amdgcn_sched_barrier(0)
__device__ __forceinline__ int crow(int r, int hi) { return (r & 3) + 8 * (r >> 2) + 4 * hi; }
constexpr float AT_SCALE = 0.125f, AT_THR = 8.f;
__device__ __forceinline__ void partialSM(f32x16& p0, f32x16& p1, float& m_reg, float& mn, float& alpha) {
    constexpr float C = AT_SCALE * 1.4426950408889634f;
    float pmax = p0[0];
#pragma unroll
    for (int r = 1; r < 16; ++r) pmax = fmaxf(pmax, p0[r]);
#pragma unroll
    for (int r = 0; r < 16; ++r) pmax = fmaxf(pmax, p1[r]);
    { auto rr = __builtin_amdgcn_permlane32_swap(__float_as_uint(pmax), __float_as_uint(pmax), false, false);
      pmax = fmaxf(__uint_as_float(rr[0]), __uint_as_float(rr[1])); }
    if (__builtin_expect(__all(pmax - m_reg <= AT_THR / AT_SCALE), 1)) { mn = m_reg; alpha = 1.f; }
    else { mn = fmaxf(m_reg, pmax); alpha = __builtin_amdgcn_exp2f((m_reg - mn) * C); m_reg = mn; }
    const float mnC = -mn * C;
#pragma unroll
    for (int r = 0; r < 16; ++r) p0[r] = fmaf(p0[r], C, mnC);
#pragma unroll
    for (int r = 0; r < 16; ++r) p1[r] = fmaf(p1[r], C, mnC);
#pragma unroll
    for (int r = 0; r < 16; ++r) p0[r] = __builtin_amdgcn_exp2f(p0[r]);
}
__device__ __forceinline__ void finishSM(f32x16& p0, f32x16& p1, float alpha, float& l_reg, bf16x8& pa0, bf16x8& pa1, bf16x8& pa2, bf16x8& pa3) {
#pragma unroll
    for (int r = 0; r < 16; ++r) p1[r] = __builtin_amdgcn_exp2f(p1[r]);
    float ps = 0;
#pragma unroll
    for (int r = 0; r < 16; ++r) ps += p0[r];
#pragma unroll
    for (int r = 0; r < 16; ++r) ps += p1[r];
    { auto rr = __builtin_amdgcn_permlane32_swap(__float_as_uint(ps), __float_as_uint(ps), false, false);
      ps = __uint_as_float(rr[0]) + __uint_as_float(rr[1]); }
    l_reg = l_reg * alpha + ps;
#define PK4(P, BASE, OUT) do { unsigned a0 = cvt_pk_bf16(P[BASE + 0], P[BASE + 1]), a1 = cvt_pk_bf16(P[BASE + 2], P[BASE + 3]);   \
    unsigned b0 = cvt_pk_bf16(P[BASE + 4], P[BASE + 5]), b1 = cvt_pk_bf16(P[BASE + 6], P[BASE + 7]);                              \
    auto r0 = __builtin_amdgcn_permlane32_swap(a0, b0, false, false); auto r1 = __builtin_amdgcn_permlane32_swap(a1, b1, false, false); \
    u32x4 w = {r0[0], r1[0], r0[1], r1[1]}; OUT = *reinterpret_cast<bf16x8*>(&w); } while (0)
    PK4(p0, 0, pa0); PK4(p0, 8, pa1); PK4(p1, 0, pa2); PK4(p1, 8, pa3);
#undef PK4
}
__device__ __forceinline__ void qkt(f32x16& p0, f32x16& p1, const LAS char* Ks, const bf16x8 (&qr)[4], int r32, int hi) {
    p0 = f32x16{}; p1 = f32x16{};
#pragma unroll
    for (int d0 = 0; d0 < 4; ++d0) { const int cb = (d0 * 16 + hi * 8) * 2;
        const bf16x8 b0 = *(const LAS bf16x8*)(Ks + KSWZ64(r32, cb));
        const bf16x8 b1 = *(const LAS bf16x8*)(Ks + KSWZ64(32 + r32, cb));
        p0 = __builtin_amdgcn_mfma_f32_32x32x16_bf16(b0, qr[d0], p0, 0, 0, 0);
        p1 = __builtin_amdgcn_mfma_f32_32x32x16_bf16(b1, qr[d0], p1, 0, 0, 0); }
}
__device__ __forceinline__ int v_st(int k, int c) { const int kk = (k & ~0xC) | ((k & 4) << 1) | ((k & 8) >> 1); return ((kk >> 3) * 4 + (c >> 5)) * 512 + ((kk & 7) * 32 + (c & 31)) * 2; }
__device__ __forceinline__ int v_rd_base(int lane) { return ((lane & 3) << 3) | (((lane >> 2) & 3) << 6) | (((lane >> 4) & 1) << 5) | (((lane >> 5) & 1) << 8); }
constexpr int v_rd_off(int d0, int ks, int half) { return d0 * 512 + ks * 4096 + half * 2048; }
template <int OFF> __device__ __forceinline__ s16x4 tr_read(int vb) {
    s16x4 r; asm volatile("ds_read_b64_tr_b16 %0, %1 offset:%2" : "=&v"(r) : "v"(vb), "i"(OFF) : "memory"); return r;
}
template <int D0> __device__ __forceinline__ void pv_one(f32x16& od, int vb, bf16x8 pa0, bf16x8 pa1, bf16x8 pa2, bf16x8 pa3) {
    const s16x4 l0 = tr_read<v_rd_off(D0, 0, 0)>(vb), h0 = tr_read<v_rd_off(D0, 0, 1)>(vb), l1 = tr_read<v_rd_off(D0, 1, 0)>(vb), h1 = tr_read<v_rd_off(D0, 1, 1)>(vb);
    const s16x4 l2 = tr_read<v_rd_off(D0, 2, 0)>(vb), h2 = tr_read<v_rd_off(D0, 2, 1)>(vb), l3 = tr_read<v_rd_off(D0, 3, 0)>(vb), h3 = tr_read<v_rd_off(D0, 3, 1)>(vb);
    asm volatile("s_waitcnt lgkmcnt(0)" ::: "memory"); SBAR();
#define PK(L, H) (bf16x8){L[0], L[1], L[2], L[3], H[0], H[1], H[2], H[3]}
    od = __builtin_amdgcn_mfma_f32_32x32x16_bf16(pa0, PK(l0, h0), od, 0, 0, 0);
    od = __builtin_amdgcn_mfma_f32_32x32x16_bf16(pa1, PK(l1, h1), od, 0, 0, 0);
    od = __builtin_amdgcn_mfma_f32_32x32x16_bf16(pa2, PK(l2, h2), od, 0, 0, 0);
    od = __builtin_amdgcn_mfma_f32_32x32x16_bf16(pa3, PK(l3, h3), od, 0, 0, 0);
#undef PK
}
__device__ __forceinline__ void pv_d0(f32x16 (&o)[4], int vb, bf16x8 pa0, bf16x8 pa1, bf16x8 pa2, bf16x8 pa3) {
    pv_one<0>(o[0], vb, pa0, pa1, pa2, pa3); pv_one<1>(o[1], vb, pa0, pa1, pa2, pa3); pv_one<2>(o[2], vb, pa0, pa1, pa2, pa3); pv_one<3>(o[3], vb, pa0, pa1, pa2, pa3);
}
template <int pass> __device__ __forceinline__ void attn_pass(const bf16* Z, float* O1, int qrow0, int crow0, int lrow0, int ntc, int nt, int h, LAS char* lds, int wv) {
    const int tid = tid_opaque(wv), wid = tid >> 6, lane = tid & 63, r32 = lane & 31, hi = lane >> 5;
    LAS char* V_lds = lds; LAS char* K_lds = lds + 2 * AT_SHM_V;
    LAS float* ws = (LAS float*)(lds + 2 * AT_SHM_V + 2 * AT_SHM_K) + wid * 64; LAS float* li_l = ws; LAS float* al_l = ws + 32;
    const int sr = tid >> 4, sc = (tid & 15) * 8, vst0 = v_st(sr, sc), vst1 = v_st(32 + sr, sc);
    const int srk = tid >> 3, sck = (tid & 7) * 8;
    const int vgo0 = sr * ZC + sc, kgo0 = srk * ZC + sck, kst0 = KSWZ64(srk, sck * 2);
    const int vb0 = (int)(uintptr_t)V_lds + v_rd_base(lane);
    {
        float m_reg = -1e30f, l_reg = 0; f32x16 o[4] = {}; bf16x8 qr[4];
        const bf16* Qw = Z + (size_t)(qrow0 + wid * 32 + r32) * ZC + 1280 + h * 128 + pass * 64 + hi * 8;
#pragma unroll
        for (int d0 = 0; d0 < 4; ++d0) qr[d0] = *(const bf16x8*)(Qw + d0 * 16);
        const bf16* Kc = Z + 1792 + h * 128 + pass * 64; const bf16* Vc = Z + 2304 + h * 128;
        struct { bf16x8 vs0, vs1, ks0; } sr_[2];
#define KROW(t) ((t) < ntc ? crow0 + (t) * 64 : lrow0 + ((t) - ntc) * 64)
#define SLOAD(i, t) do { const size_t _r = (size_t)__builtin_amdgcn_readfirstlane(KROW(t)) * ZC; const bf16* _v = Vc + _r; const bf16* _k = Kc + _r; \
    sr_[i].vs0 = *(const bf16x8*)(_v + vgo0); sr_[i].vs1 = *(const bf16x8*)(_v + vgo0 + 32 * ZC); sr_[i].ks0 = *(const bf16x8*)(_k + kgo0); } while (0)
#define SWRITE(b, i) do { *(LAS bf16x8*)(V_lds + (b) * AT_SHM_V + vst0) = sr_[i].vs0; *(LAS bf16x8*)(V_lds + (b) * AT_SHM_V + vst1) = sr_[i].vs1; \
    *(LAS bf16x8*)(K_lds + (b) * AT_SHM_K + kst0) = sr_[i].ks0; } while (0)
#define SWAIT() asm volatile("s_waitcnt vmcnt(3)" ::: "memory")
#define RESC(a) do { if (__any((a) < 1.f)) { if (hi == 0) al_l[r32] = (a); asm volatile("s_waitcnt lgkmcnt(0)" ::: "memory"); \
    _Pragma("unroll") for (int d = 0; d < 4; ++d) _Pragma("unroll") for (int r = 0; r < 16; ++r) o[d][r] *= al_l[crow(r, hi)]; } } while (0)
        f32x16 pA0, pA1, pB0, pB1; float mnA, mnB, alA, alB; bf16x8 pa0, pa1, pa2, pa3;
        __syncthreads();
        SLOAD(0, 0); asm volatile("s_waitcnt vmcnt(0)" ::: "memory"); SWRITE(0, 0); __syncthreads();
        qkt(pA0, pA1, K_lds, qr, r32, hi); partialSM(pA0, pA1, m_reg, mnA, alA);
        SLOAD(1, 1); if (2 < nt) SLOAD(0, 2);
        SWAIT(); SWRITE(1, 1); __syncthreads();
        for (int j = 1; j + 1 < nt; j += 2) {
            SBAR(); qkt(pB0, pB1, K_lds + AT_SHM_K, qr, r32, hi);
            finishSM(pA0, pA1, alA, l_reg, pa0, pa1, pa2, pa3); SBAR();
            SLOAD(1, j + 2); SBAR();
            pv_d0(o, vb0, pa0, pa1, pa2, pa3); partialSM(pB0, pB1, m_reg, mnB, alB);
            __syncthreads(); SWAIT(); SWRITE(0, 0);
            RESC(alB); __syncthreads();
            SBAR(); qkt(pA0, pA1, K_lds, qr, r32, hi);
            finishSM(pB0, pB1, alB, l_reg, pa0, pa1, pa2, pa3); SBAR();
            if (j + 3 < nt) SLOAD(0, j + 3); SBAR();
            pv_d0(o, vb0 + AT_SHM_V, pa0, pa1, pa2, pa3); partialSM(pA0, pA1, m_reg, mnA, alA);
            __syncthreads(); SWAIT(); SWRITE(1, 1);
            RESC(alA); __syncthreads();
        }
        SBAR(); qkt(pB0, pB1, K_lds + AT_SHM_K, qr, r32, hi);
        finishSM(pA0, pA1, alA, l_reg, pa0, pa1, pa2, pa3); SBAR();
        pv_d0(o, vb0, pa0, pa1, pa2, pa3); partialSM(pB0, pB1, m_reg, mnB, alB);
        __syncthreads(); RESC(alB);
        finishSM(pB0, pB1, alB, l_reg, pa0, pa1, pa2, pa3); SBAR();
        pv_d0(o, vb0 + AT_SHM_V, pa0, pa1, pa2, pa3);
        if (hi == 0) li_l[r32] = l_reg; asm volatile("s_waitcnt lgkmcnt(0)" ::: "memory");
#pragma unroll
        for (int r = 0; r < 16; ++r) { const float rl_ = __builtin_amdgcn_rcpf(li_l[crow(r, hi)]);
#pragma unroll
            for (int d0 = 0; d0 < 4; ++d0) o[d0][r] *= rl_; }
        const int orow0 = qrow0 + wid * 32;
        float* Op = O1 + (size_t)pass * ((size_t)R * 512);
#pragma unroll
        for (int r = 0; r < 16; ++r)
#pragma unroll
            for (int d0 = 0; d0 < 4; ++d0) Op[(size_t)(orow0 + crow(r, hi)) * 512 + h * 128 + d0 * 32 + r32] = o[d0][r];
    }
#undef KROW
#undef SLOAD
#undef SWRITE
#undef SWAIT
#undef RESC
}
__device__ __forceinline__ void attn_combine(float* O1, bf16* Y, int qrow0, int h, float lam, float osc, const float* subg, int wv) {
    const int tid = tid_opaque(wv), wid = tid >> 6, lane = tid & 63;
    asm volatile("s_waitcnt vmcnt(0)" ::: "memory");
    {
        const float* O2 = O1 + (size_t)R * 512; const int orow0 = qrow0 + wid * 32;
        const float g0 = subg[lane] * osc, g1 = subg[64 + lane] * osc;
        for (int rr = 0; rr < 32; ++rr) {
            const size_t o_ = (size_t)(orow0 + rr) * 512 + h * 128 + lane;
            const float a0 = __hip_atomic_load(O1 + o_, __ATOMIC_RELAXED, __HIP_MEMORY_SCOPE_AGENT), a1 = __hip_atomic_load(O1 + o_ + 64, __ATOMIC_RELAXED, __HIP_MEMORY_SCOPE_AGENT);
            const float b0 = __hip_atomic_load(O2 + o_, __ATOMIC_RELAXED, __HIP_MEMORY_SCOPE_AGENT), b1 = __hip_atomic_load(O2 + o_ + 64, __ATOMIC_RELAXED, __HIP_MEMORY_SCOPE_AGENT);
            const float v0 = a0 - lam * b0, v1 = a1 - lam * b1;
            const float ss = wave_sum(v0 * v0 + v1 * v1);
            const float rs = 1.0f / sqrtf(ss * (1.f / 128.f) + RMS_EPS);
            bf16* yr = Y + (size_t)(orow0 + rr) * YC + 512 + h * 128 + lane;
            yr[0] = f2bf(v0 * rs * g0); yr[64] = f2bf(v1 * rs * g1);
        }
    }
}

__device__ __forceinline__ float dpp_row_sum(float v) {
    v += __int_as_float(__builtin_amdgcn_update_dpp(0, __float_as_int(v), 0xB1, 0xF, 0xF, true));
    v += __int_as_float(__builtin_amdgcn_update_dpp(0, __float_as_int(v), 0x4E, 0xF, 0xF, true));
    v += __int_as_float(__builtin_amdgcn_update_dpp(0, __float_as_int(v), 0x141, 0xF, 0xF, true));
    v += __int_as_float(__builtin_amdgcn_update_dpp(0, __float_as_int(v), 0x140, 0xF, 0xF, true));
    return v;
}
__device__ __forceinline__ float dpp_row_max(float v) {
    v = fmaxf(v, __int_as_float(__builtin_amdgcn_update_dpp(0, __float_as_int(v), 0xB1, 0xF, 0xF, true)));
    v = fmaxf(v, __int_as_float(__builtin_amdgcn_update_dpp(0, __float_as_int(v), 0x4E, 0xF, 0xF, true)));
    v = fmaxf(v, __int_as_float(__builtin_amdgcn_update_dpp(0, __float_as_int(v), 0x141, 0xF, 0xF, true)));
    v = fmaxf(v, __int_as_float(__builtin_amdgcn_update_dpp(0, __float_as_int(v), 0x140, 0xF, 0xF, true)));
    return v;
}
__device__ __forceinline__ float wave_sum_fast(float v) {
    v = dpp_row_sum(v);
    const float r0 = __int_as_float(__builtin_amdgcn_readlane(__float_as_int(v), 0)), r1 = __int_as_float(__builtin_amdgcn_readlane(__float_as_int(v), 16));
    const float r2 = __int_as_float(__builtin_amdgcn_readlane(__float_as_int(v), 32)), r3 = __int_as_float(__builtin_amdgcn_readlane(__float_as_int(v), 48));
    return (r0 + r1) + (r2 + r3);
}
__device__ __forceinline__ void row_stats(const f32x4 (&v)[4], float& mean, float& rstd) {
    float s = 0.f;
#pragma unroll
    for (int j = 0; j < 4; ++j) s += (v[j][0] + v[j][1]) + (v[j][2] + v[j][3]);
    mean = wave_sum_fast(s) * (1.f / D); float q = 0.f;
#pragma unroll
    for (int j = 0; j < 4; ++j) { const f32x4 d = v[j] - mean; q += (d[0] * d[0] + d[1] * d[1]) + (d[2] * d[2] + d[3] * d[3]); }
    rstd = 1.0f / sqrtf(wave_sum_fast(q) * (1.f / D) + LN_EPS);
}
template <bool WANT>
__device__ __forceinline__ void store_h(bf16* HLrow, const f32x4 (&v)[4], float mean, float rstd, const float* shift, const float* scale, int lane, f32x4 (&hv)[4]) {
#pragma unroll
    for (int j = 0; j < 4; ++j) { const int c = 4 * lane + 256 * j; const f32x4 sh = *(const f32x4*)(shift + c), sc = *(const f32x4*)(scale + c);
        const f32x4 h = (v[j] - mean) * rstd * (sc + 1.f) + sh; u32x2 w; w.x = cvt_pk_bf16(h[0], h[1]); w.y = cvt_pk_bf16(h[2], h[3]); *(u32x2*)(HLrow + c) = w; if (WANT) hv[j] = h; }
}
template <int MODE>
__device__ __forceinline__ void ph_ln(const Args& a, int l, bool last, LAS unsigned char* lds, int G, int wg, int wv) {
    const int tid = tid_opaque(wv), lane = tid & 63, wave = tid >> 6, gw = wg * 8 + wave, NGW = G * 8;
    float* X = (float*)(a.ws + WS_X); bf16* HL = (bf16*)(a.ws + WS_HL); const float* ADA = (const float*)(a.ws + WS_ADA);
    LAS float* wr_l = (LAS float*)lds;
    if (MODE == 1) {
        const float* wrt = a.in[I_WROUTER] + (size_t)l * D * NE;
        for (int i = tid; i < D * NE; i += 512) { const int k = i >> 4, e = i & 15; wr_l[e * D + k] = wrt[i]; }
        __syncthreads();
    }
    const int nrows = (MODE != 0 && last) ? RL : R;
    for (int row0 = gw * 2; row0 < nrows; row0 += NGW * 2) {
        const int bc = row0 < RL ? (row0 >> 11) : 8;
        f32x4 v[2][4]; float mean[2], rstd[2];
        if (MODE == 0) {
#pragma unroll
            for (int rr = 0; rr < 2; ++rr) { const int row = row0 + rr; const float* src = row < RL ? a.in[I_X] + (size_t)row * D : a.in[I_CTX] + (size_t)(row - RL) * D;
#pragma unroll
                for (int j = 0; j < 4; ++j) { v[rr][j] = *(const f32x4*)(src + 4 * lane + 256 * j); *(f32x4*)(X + (size_t)row * D + 4 * lane + 256 * j) = v[rr][j]; } }
            const float* ad = ADA + (size_t)(0 * 9 + bc) * 6144; f32x4 hv[4];
#pragma unroll
            for (int rr = 0; rr < 2; ++rr) { row_stats(v[rr], mean[rr], rstd[rr]); store_h<false>(HL + (size_t)(row0 + rr) * D, v[rr], mean[rr], rstd[rr], ad, ad + 1024, lane, hv); }
        } else {
            const float* ad = ADA + (size_t)(l * 9 + bc) * 6144;
            const float* gate = ad + (MODE == 1 ? 2048 : 5120);
            if (MODE == 1) {
                f32x4 tv[2][4];
#pragma unroll
                for (int rr = 0; rr < 2; ++rr) { const float* T = (const float*)(a.ws + WS_R2) + (size_t)(row0 + rr) * D;
#pragma unroll
                    for (int j = 0; j < 4; ++j) { const int c = 4 * lane + 256 * j; v[rr][j] = *(const f32x4*)(X + (size_t)(row0 + rr) * D + c); tv[rr][j] = *(const f32x4*)(T + c); } }
#pragma unroll
                for (int j = 0; j < 4; ++j) { const f32x4 gt = *(const f32x4*)(gate + 4 * lane + 256 * j);
#pragma unroll
                    for (int rr = 0; rr < 2; ++rr) v[rr][j] = v[rr][j] * DN_ALPHA + gt * tv[rr][j]; }
            } else {
                const bf16* YE = (const bf16*)(a.ws + WS_R2 + 72 * MiB);
                f32x4 mo[2][4];
#pragma unroll
                for (int rr = 0; rr < 2; ++rr) {
#pragma unroll
                    for (int j = 0; j < 4; ++j) { v[rr][j] = *(const f32x4*)(X + (size_t)(row0 + rr) * D + 4 * lane + 256 * j); mo[rr][j] = (f32x4){0.f, 0.f, 0.f, 0.f}; } }
                const int* INV = (const int*)(a.ws + WS_INV) + (size_t)row0 * 16;
                const int myinv = lane < 32 ? INV[lane] : -1;
                unsigned long long mask = __ballot(myinv >= 0);
                while (mask) { const int src = __builtin_ctzll(mask); mask &= mask - 1; const int r = __builtin_amdgcn_readlane(myinv, src);
                    u32x2 w[4];
#pragma unroll
                    for (int j = 0; j < 4; ++j) w[j] = *(const u32x2*)(YE + (size_t)r * 1024 + 4 * lane + 256 * j);
                    if (src < 16) {
#pragma unroll
                        for (int j = 0; j < 4; ++j) { mo[0][j][0] += bflo(w[j].x); mo[0][j][1] += bfhi(w[j].x); mo[0][j][2] += bflo(w[j].y); mo[0][j][3] += bfhi(w[j].y); }
                    } else {
#pragma unroll
                        for (int j = 0; j < 4; ++j) { mo[1][j][0] += bflo(w[j].x); mo[1][j][1] += bfhi(w[j].x); mo[1][j][2] += bflo(w[j].y); mo[1][j][3] += bfhi(w[j].y); }
                    } }
#pragma unroll
                for (int j = 0; j < 4; ++j) { const f32x4 gt = *(const f32x4*)(gate + 4 * lane + 256 * j);
#pragma unroll
                    for (int rr = 0; rr < 2; ++rr) v[rr][j] = v[rr][j] * DN_ALPHA + gt * mo[rr][j]; }
            }
#pragma unroll
            for (int rr = 0; rr < 2; ++rr) row_stats(v[rr], mean[rr], rstd[rr]);
            const float* g = a.in[MODE == 1 ? I_LN1G : I_LN2G] + l * D; const float* b = a.in[MODE == 1 ? I_LN1B : I_LN2B] + l * D;
#pragma unroll
            for (int j = 0; j < 4; ++j) { const int c = 4 * lane + 256 * j; const f32x4 gg = *(const f32x4*)(g + c), bb = *(const f32x4*)(b + c);
#pragma unroll
                for (int rr = 0; rr < 2; ++rr) { v[rr][j] = (v[rr][j] - mean[rr]) * rstd[rr] * gg + bb; *(f32x4*)(X + (size_t)(row0 + rr) * D + c) = v[rr][j];
                    if (MODE == 2 && last) *(f32x4*)(a.out + (size_t)(row0 + rr) * D + c) = v[rr][j]; } }
            if (MODE == 1 || !last) {
                const float* ad2 = MODE == 1 ? ad + 3072 : ADA + (size_t)((l + 1) * 9 + bc) * 6144;
#pragma unroll
                for (int rr = 0; rr < 2; ++rr) row_stats(v[rr], mean[rr], rstd[rr]);
#pragma unroll
                for (int rr = 0; rr < 2; ++rr) {
                    f32x4 hv[4];
                    store_h<MODE == 1>(HL + (size_t)(row0 + rr) * D, v[rr], mean[rr], rstd[rr], ad2, ad2 + 1024, lane, hv);
                    if (MODE == 1) {
                        float lg[16];
#pragma unroll
                        for (int e = 0; e < 16; ++e) { float s_ = 0.f;
#pragma unroll
                            for (int j = 0; j < 4; ++j) { const f32x4 w = *(const LAS f32x4*)(wr_l + e * D + 4 * lane + 256 * j); s_ += (hv[j][0] * w[0] + hv[j][1] * w[1]) + (hv[j][2] * w[2] + hv[j][3] * w[3]); }
                            lg[e] = dpp_row_sum(s_); }
                        float m_ = 0.f;
#pragma unroll
                        for (int e = 0; e < 16; ++e) m_ = ((lane & 15) == e) ? lg[e] : m_;
                        m_ += __shfl_xor(m_, 16); m_ += __shfl_xor(m_, 32);
                        const float mx = dpp_row_max(m_), ex = expf(m_ - mx), se = dpp_row_sum(ex);
                        float* AFF = (float*)(a.ws + WS_AFF); const int row = row0 + rr;
                        if (lane < 16) {
                            if (row < RL) AFF[((size_t)(row >> 11) * 16 + lane) * 2048 + (row & 2047)] = ex / se;
                            else { const int rc = row - RL; AFF[(size_t)8 * 16 * 2048 + ((size_t)(rc >> 8) * 16 + lane) * 256 + (rc & 255)] = ex / se; }
                        }
                    }
                }
            }
        }
    }
}

__device__ __forceinline__ int block_excl_scan(int v, LAS int* wtot, int lane, int wave, int& total) {
    int inc = v;
#pragma unroll
    for (int o = 1; o < 64; o <<= 1) { const int t = __shfl_up(inc, o); if (lane >= o) inc += t; }
    if (lane == 63) wtot[wave] = inc;
    __syncthreads();
    int base = 0, tot = 0;
#pragma unroll
    for (int w = 0; w < 8; ++w) { const int x = wtot[w]; tot += x; if (w < wave) base += x; }
    __syncthreads();
    total = tot; return base + inc - v;
}
__device__ __forceinline__ void ph_topk(const Args& a, bool last, LAS unsigned char* lds, int G, int wg, int wv) {
    const int tid = tid_opaque(wv), lane = tid & 63, wave = tid >> 6;
    LAS unsigned* cnt = (LAS unsigned*)lds; LAS int* wtot = (LAS int*)(lds + 256);
    const float* AFF = (const float*)(a.ws + WS_AFF); int* IDX = (int*)(a.ws + WS_IDX); float* GV = (float*)(a.ws + WS_GV); int* INV = (int*)(a.ws + WS_INV);
    const int nunits = last ? 128 : 256;
    for (int u = wg; u < nunits; u += G) {
        const bool lat = u < 128; const int b = lat ? (u >> 4) : ((u - 128) >> 4), e = u & 15;
        const int n = lat ? 2048 : 256, cap = lat ? CAPL : CAPC;
        const float* af = lat ? AFF + ((size_t)b * 16 + e) * 2048 : AFF + (size_t)8 * 16 * 2048 + ((size_t)b * 16 + e) * 256;
        const int rowbase = lat ? b * 2048 : RL + b * 256;
        const int hid0 = lat ? (e * 8 + b) * 256 : 32768 + e * 256 + b * 32;
        unsigned key[4]; const int t0 = 4 * tid;
        if (t0 < n) { const u32x4 kv = *(const u32x4*)(af + t0); key[0] = kv.x; key[1] = kv.y; key[2] = kv.z; key[3] = kv.w; } else { key[0] = key[1] = key[2] = key[3] = 0u; }
        if (tid < 32) cnt[tid] = 0u;
        __syncthreads();
        unsigned prefix = 0u; int rem = cap;
        for (int bit = 30; bit >= 0; --bit) {
            const unsigned want = (prefix >> bit) | 1u;
            int c = 0;
#pragma unroll
            for (int j = 0; j < 4; ++j) c += ((key[j] >> bit) == want) ? 1 : 0;
            c = wave_sum_i(c);
            if (lane == 0 && c) __hip_atomic_fetch_add(&cnt[bit], (unsigned)c, __ATOMIC_RELAXED, __HIP_MEMORY_SCOPE_WORKGROUP);
            __syncthreads();
            const int tot = (int)cnt[bit];
            if (tot >= rem) prefix |= (1u << bit); else rem -= tot;
        }
        int eqc = 0;
#pragma unroll
        for (int j = 0; j < 4; ++j) eqc += (key[j] == prefix) ? 1 : 0;
        int dummy; int eqb = block_excl_scan(eqc, wtot, lane, wave, dummy);
        bool sel[4]; int selc = 0;
#pragma unroll
        for (int j = 0; j < 4; ++j) { bool s = key[j] > prefix; if (key[j] == prefix) { s = eqb < rem; ++eqb; } sel[j] = s; selc += s ? 1 : 0; }
        int slot = block_excl_scan(selc, wtot, lane, wave, dummy);
        if (t0 < n) {
#pragma unroll
            for (int j = 0; j < 4; ++j) { const int row = rowbase + t0 + j;
                if (sel[j]) { IDX[hid0 + slot] = row; GV[hid0 + slot] = __uint_as_float(key[j]); INV[(size_t)row * 16 + e] = hid0 + slot; ++slot; }
                else INV[(size_t)row * 16 + e] = -1; }
        }
        __syncthreads();
    }
}

constexpr int VT_LD = 136;
__device__ __forceinline__ void ph_prep(const Args& a, int l, bool last, LAS unsigned char* lds, int G, int wg, int wv) {
    const int tid = tid_opaque(wv), lane = tid & 63, wave = __builtin_amdgcn_readfirstlane(tid >> 6), fr = lane & 15, fq = lane >> 4;
    const bf16* Z = (const bf16*)(a.ws + WS_R1); bf16* Y = (bf16*)(a.ws + WS_Y);
    const bf16* Wb = (const bf16*)(a.ws + WS_WSPB) + (size_t)l * 4 * 128 * 128;
    LAS bf16* vT = (LAS bf16*)lds;
    const int nch = last ? 128 : 144;
    for (int ck = wg; ck < nch; ck += G) {
        const int r0 = ck * 128;
        {
            float g[4], bb[4];
#pragma unroll
            for (int i = 0; i < 4; ++i) { g[i] = a.in[I_SGUG][l * 256 + lane + 64 * i]; bb[i] = a.in[I_SGUB][l * 256 + lane + 64 * i]; }
#pragma unroll 2
            for (int i2 = 0; i2 < 8; ++i2) { const int q = wave * 16 + i2 * 2;
                float x[2][4];
#pragma unroll
                for (int rr = 0; rr < 2; ++rr)
#pragma unroll
                    for (int i = 0; i < 4; ++i) x[rr][i] = bf2f(Z[(size_t)(r0 + q + rr) * ZC + 256 + lane + 64 * i]);
#pragma unroll
                for (int rr = 0; rr < 2; ++rr) {
                    const float mean = wave_sum_fast((x[rr][0] + x[rr][1]) + (x[rr][2] + x[rr][3])) * (1.f / 256.f);
#pragma unroll
                    for (int i = 0; i < 4; ++i) x[rr][i] -= mean;
                    const float var = wave_sum_fast((x[rr][0] * x[rr][0] + x[rr][1] * x[rr][1]) + (x[rr][2] * x[rr][2] + x[rr][3] * x[rr][3])) * (1.f / 256.f);
                    const float rstd = 1.0f / sqrtf(var + LN_EPS);
#pragma unroll
                    for (int i = 0; i < 4; ++i) x[rr][i] = x[rr][i] * rstd * g[i] + bb[i];
                }
#pragma unroll
                for (int i = 0; i < 4; ++i) *(LAS unsigned*)(vT + (lane + 64 * i) * VT_LD + q) = cvt_pk_bf16(x[0][i], x[1][i]);
            }
        }
        __syncthreads();
        {
            const int g = wave & 3, ph = wave >> 2;
            f32x4 acc[4][4];
#pragma unroll
            for (int ct = 0; ct < 4; ++ct)
#pragma unroll
                for (int pt = 0; pt < 4; ++pt) acc[ct][pt] = (f32x4){0.f, 0.f, 0.f, 0.f};
            const bf16* Wg = Wb + (size_t)(g * 128 + ph * 64 + fr) * 128 + fq * 8;
            const LAS bf16* vA = vT + (g * 64 + fr) * VT_LD + fq * 8;
#pragma unroll
            for (int kk = 0; kk < 4; ++kk) {
                bf16x8 af[4], bfm[4];
#pragma unroll
                for (int ct = 0; ct < 4; ++ct) af[ct] = *(const LAS bf16x8*)(vA + ct * 16 * VT_LD + kk * 32);
#pragma unroll
                for (int pt = 0; pt < 4; ++pt) bfm[pt] = *(const bf16x8*)(Wg + pt * 16 * 128 + kk * 32);
#pragma unroll
                for (int ct = 0; ct < 4; ++ct)
#pragma unroll
                    for (int pt = 0; pt < 4; ++pt) acc[ct][pt] = __builtin_amdgcn_mfma_f32_16x16x32_bf16(af[ct], bfm[pt], acc[ct][pt], 0, 0, 0);
            }
            const float* bsp = a.in[I_BSP] + (l * 4 + g) * 128;
#pragma unroll
            for (int pt = 0; pt < 4; ++pt) { const int p = ph * 64 + pt * 16 + fr; const float bias = bsp[p]; const size_t row = (size_t)(r0 + p);
#pragma unroll
                for (int ct = 0; ct < 4; ++ct) { const int c = g * 64 + ct * 16 + 4 * fq; const u32x2 uw = *(const u32x2*)(Z + row * ZC + c);
                    u32x2 o; o.x = cvt_pk_bf16(bflo(uw.x) * (acc[ct][pt][0] + bias), bfhi(uw.x) * (acc[ct][pt][1] + bias)); o.y = cvt_pk_bf16(bflo(uw.y) * (acc[ct][pt][2] + bias), bfhi(uw.y) * (acc[ct][pt][3] + bias));
                    *(u32x2*)(Y + row * YC + c) = o; } }
        }
        {
            const int c0 = (tid & 31) * 8, rr0 = tid >> 5; const int seqlen = r0 < RL ? 2048 : 256;
            float w0[8], w1[8], w2[8];
#pragma unroll
            for (int j = 0; j < 8; ++j) { w0[j] = a.in[I_CONVW][(l * 3 + 0) * 256 + c0 + j]; w1[j] = a.in[I_CONVW][(l * 3 + 1) * 256 + c0 + j]; w2[j] = a.in[I_CONVW][(l * 3 + 2) * 256 + c0 + j]; }
            for (int ps = 0; ps < 8; ++ps) { const int row = r0 + ps * 16 + rr0; const bf16* zr = Z + (size_t)row * ZC;
                const bool hp = (row % seqlen) != 0, hn = ((row + 1) % seqlen) != 0;
                float yc[8], yp[8], yn[8], gbv[8], t0[8], t1[8];
                unpack8(*(const u32x4*)(zr + 768 + c0), t0); unpack8(*(const u32x4*)(zr + 1024 + c0), t1);
#pragma unroll
                for (int j = 0; j < 8; ++j) yc[j] = t0[j] * t1[j];
                if (hp) { unpack8(*(const u32x4*)(zr - ZC + 768 + c0), t0); unpack8(*(const u32x4*)(zr - ZC + 1024 + c0), t1); }
#pragma unroll
                for (int j = 0; j < 8; ++j) yp[j] = hp ? t0[j] * t1[j] : 0.f;
                if (hn) { unpack8(*(const u32x4*)(zr + ZC + 768 + c0), t0); unpack8(*(const u32x4*)(zr + ZC + 1024 + c0), t1); }
#pragma unroll
                for (int j = 0; j < 8; ++j) yn[j] = hn ? t0[j] * t1[j] : 0.f;
                unpack8(*(const u32x4*)(zr + 512 + c0), gbv);
                f32x4 o0, o1;
#pragma unroll
                for (int j = 0; j < 4; ++j) { o0[j] = gbv[j] * (w0[j] * yp[j] + w1[j] * yc[j] + w2[j] * yn[j]); o1[j] = gbv[4 + j] * (w0[4 + j] * yp[4 + j] + w1[4 + j] * yc[4 + j] + w2[4 + j] * yn[4 + j]); }
                *(u32x4*)(Y + (size_t)row * YC + 256 + c0) = pack8(o0, o1);
            }
        }
        __syncthreads();
    }
}

__device__ __forceinline__ void ph_ada(const Args& a, LAS unsigned char* lds, int G, int wg, int wv) {
    const int tid = tid_opaque(wv);
    LAS float* sc = (LAS float*)lds; LAS float* red = sc + 9 * 1024;
    for (int i = tid; i < 9 * 1024; i += 512) { const int bc = i >> 10, k = i & 1023; const float v = bc < 8 ? a.in[I_C][bc * 1024 + k] : a.in[I_CCTX][k]; sc[i] = v / (1.f + expf(-v)); }
    __syncthreads();
    float* ADA = (float*)(a.ws + WS_ADA);
    for (int u = wg; u < 96; u += G) {
        const int l = u / 24, cb = u % 24, cl = tid & 255, col = cb * 256 + cl, kh = tid >> 8;
        const float* w = a.in[I_WADA] + (size_t)l * 1024 * 6144 + col;
        float acc[9];
#pragma unroll
        for (int bc = 0; bc < 9; ++bc) acc[bc] = 0.f;
#pragma unroll 8
        for (int k = kh * 512; k < kh * 512 + 512; ++k) { const float wv = w[(size_t)k * 6144];
#pragma unroll
            for (int bc = 0; bc < 9; ++bc) acc[bc] += sc[bc * 1024 + k] * wv; }
        if (kh == 1) {
#pragma unroll
            for (int bc = 0; bc < 9; ++bc) red[cl * 9 + bc] = acc[bc]; }
        __syncthreads();
        if (kh == 0) { const float bv = a.in[I_BADA][l * 6144 + col];
#pragma unroll
            for (int bc = 0; bc < 9; ++bc) ADA[(size_t)(l * 9 + bc) * 6144 + col] = acc[bc] + red[cl * 9 + bc] + bv; }
        __syncthreads();
    }
}
template <class RowMap>
__device__ __forceinline__ void transpose_item(const float* W, int ldw, int k0, int n0, const RowMap& rm, LAS float* scr, int lane) {
#pragma unroll 8
    for (int i = 0; i < 32; ++i) { const int kk = 2 * i + (lane >> 5); scr[kk * 33 + (lane & 31)] = W[(size_t)(k0 + kk) * ldw + n0 + (lane & 31)]; }
    LDS_WAIT(); asm volatile("" ::: "memory");
    const int c = lane & 7;
#pragma unroll
    for (int j = 0; j < 4; ++j) { const int n = (lane >> 3) + 8 * j; const LAS float* s = scr + (8 * c) * 33 + n;
        u32x4 o; o.x = cvt_pk_bf16(s[0 * 33], s[1 * 33]); o.y = cvt_pk_bf16(s[2 * 33], s[3 * 33]); o.z = cvt_pk_bf16(s[4 * 33], s[5 * 33]); o.w = cvt_pk_bf16(s[6 * 33], s[7 * 33]);
        *(u32x4*)(rm(n0 + n) + k0 + 8 * c) = o; }
    LDS_WAIT(); asm volatile("" ::: "memory");
}
__device__ __forceinline__ void ph_weights(const Args& a, LAS unsigned char* lds, int G, int wg, int wv) {
    const int tid = tid_opaque(wv), lane = tid & 63, wave = __builtin_amdgcn_readfirstlane(tid >> 6), gw = wg * 8 + wave, NGW = G * 8;
    LAS float* scr = (LAS float*)(lds + wave * 16384);
    constexpr int C0 = 1408, C1 = C0 + 2048, C2 = C1 + 128, C3 = C2 + 128, C4 = C3 + 256, C5 = C4 + 128, C6 = C5 + 512, C7 = C6 + 512, C8 = C7 + 8192, C9 = C8 + 8192, C10 = C9 + 8192;
    for (int it = gw; it < NL * C10; it += NGW) {
        const int l = it / C10, r = it % C10;
        unsigned char* wl = a.ws + WS_W + (size_t)l * WL_STRIDE;
        if (r < C0) { const int kb = r / 88, nb = r % 88; bf16* dst = (bf16*)(wl + WL_IN);
            transpose_item(a.in[I_WIN] + (size_t)l * D * 3072, 3072, kb * 64, nb * 32, [=](int n) { return dst + (size_t)n * D; }, scr, lane); }
        else if (r < C1) { const int q = r - C0, kb = q / 128, nb = q % 128; bf16* dst = (bf16*)(wl + WL_G);
            transpose_item(a.in[I_WGATE] + (size_t)l * D * 4096, 4096, kb * 64, nb * 32,
                           [=](int n) { const int br = n >> 10, cc = n & 1023; return dst + (size_t)(((br >> 1) * 8 + (cc >> 7)) * 256 + (br & 1) * 128 + (cc & 127)) * D; }, scr, lane); }
        else if (r < C5) { int q, br, K; if (r < C2) { q = r - C1; br = 0; K = 256; } else if (r < C3) { q = r - C2; br = 1; K = 256; } else if (r < C4) { q = r - C3; br = 2; K = 512; } else { q = r - C4; br = 3; K = 256; }
            const float* src = a.in[I_WPA + br] + (size_t)l * K * D; const int kb = q / 32, nb = q % 32; bf16* dst = (bf16*)(wl + WL_P) + (size_t)br * 1024 * 512;
            transpose_item(src, D, kb * 64, nb * 32, [=](int n) { return dst + (size_t)n * 512; }, scr, lane); }
        else if (r < C7) { const int q = (r - C5) & 511, half = (r - C5) >> 9, kb = q / 32, nb = q % 32; bf16* dst = (bf16*)(wl + WL_O) + half * 1024;
            transpose_item(a.in[I_WO] + (size_t)l * D * D, D, kb * 64, nb * 32, [=](int n) { return dst + (size_t)n * M2C; }, scr, lane); }
        else if (r < C9) { const int up = r >= C8 ? 1 : 0, q = r - (up ? C8 : C7), e = q >> 9, qq = q & 511, kb = qq / 32, nb = qq % 32; bf16* dst = (bf16*)(wl + WL_GU) + (size_t)e * 2048 * D;
            transpose_item(a.in[up ? I_WEU : I_WEG] + ((size_t)l * NE + e) * D * D, D, kb * 64, nb * 32, [=](int n) { return dst + (size_t)((n >> 7) * 256 + up * 128 + (n & 127)) * D; }, scr, lane); }
        else { const int q = r - C9, e = q >> 9, qq = q & 511, kb = qq / 32, nb = qq % 32; bf16* dst = (bf16*)(wl + WL_D) + (size_t)e * D * D;
            transpose_item(a.in[I_WED] + ((size_t)l * NE + e) * D * D, D, kb * 64, nb * 32, [=](int n) { return dst + (size_t)n * D; }, scr, lane); }
    }
    __syncthreads();
    LAS float* ct = (LAS float*)lds;
    LAS float* wt = ct + 2048;
    for (int i = tid; i < 2048; i += 512) ct[i] = cospif((float)i * (1.f / 1024.f));
    __syncthreads();
    {
        bf16* FL = (bf16*)(a.ws + WS_FLAT); bf16* FC = (bf16*)(a.ws + WS_FCTX);
        const float sL = 0.022097086912079608f  , sC = 0.0625f  ;
        for (size_t i = (size_t)wg * 512 + tid; i < (size_t)2048 * 4096; i += (size_t)G * 512) { const int k1 = (int)(i >> 12), kk = (int)(i & 4095);
            const int n = kk & 2047, m = (k1 * n) & 2047; const float v = kk < 2048 ? ct[m] : -ct[(m + 1536) & 2047];
            FL[i] = f2bf(v * sL); }
        for (int i = wg * 512 + tid; i < 256 * 512; i += G * 512) { const int k1 = i >> 9, kk = i & 511; const int n = kk & 255, m = ((k1 * n) & 255) * 8;
            const float v = kk < 256 ? ct[m] : -ct[(m + 1536) & 2047]; FC[i] = f2bf(v * sC); }
    }
    {
        bf16* wb = (bf16*)(a.ws + WS_WSPB);
        for (int i = wg * 512 + tid; i < NL * 4 * 128 * 128; i += G * 512) wb[i] = f2bf(a.in[I_WSP][i]);
    }
    {
        float* rc = (float*)(a.ws + WS_ROPE); float* rs = rc + 2048 * 32;
        for (int i = wg * 512 + tid; i < 2048 * 32; i += G * 512) { const int t = i >> 5, p = i & 31; const int j = p & 15;
            const float inv = powf(10000.0f, -(float)(2 * j) / 32.0f); const float pos = p < 16 ? (float)(t >> 6) : (float)(t & 63); const float ang = pos * inv;
            rc[i] = cosf(ang); rs[i] = sinf(ang); }
        if (wg == 0 && tid < NL) { const int l = tid; float s1 = 0.f, s2 = 0.f;
            for (int k = 0; k < 64; ++k) { s1 += a.in[I_LQ1][l * 64 + k] * a.in[I_LK1][l * 64 + k]; s2 += a.in[I_LQ2][l * 64 + k] * a.in[I_LK2][l * 64 + k]; }
            ((float*)(a.ws + WS_LAM))[l] = expf(s1) - expf(s2) + (0.8f - 0.6f * expf(-0.3f * (float)l)); }
    }
    for (int u = wg; u < NL * 64; u += G) {
        const int l = u >> 6, k0 = (u & 63) * 16;
        __syncthreads();
        for (int i = tid; i < 16 * 256; i += 512) wt[i] = a.in[I_WIN][((size_t)l * D + k0 + (i >> 8)) * 3072 + 2816 + (i & 255)];
        __syncthreads();
        const int o = tid, ty = o >> 8, g = (o >> 6) & 3, k2 = o & 63;
        float acc[16];
#pragma unroll
        for (int kr = 0; kr < 16; ++kr) acc[kr] = 0.f;
        for (int c = 0; c < 64; ++c) { const int m = ((k2 * c) & 63) * 32; const float tw = ty == 0 ? ct[m] : ct[(m + 1536) & 2047];
#pragma unroll
            for (int kr = 0; kr < 16; ++kr) acc[kr] += wt[kr * 256 + g * 64 + c] * tw; }
        bf16* dst = (bf16*)(a.ws + WS_W + (size_t)l * WL_STRIDE + WL_IN) + (size_t)(2816 + o) * D + k0;
        u32x4 w0, w1;
        w0.x = cvt_pk_bf16(acc[0] * 0.125f, acc[1] * 0.125f); w0.y = cvt_pk_bf16(acc[2] * 0.125f, acc[3] * 0.125f); w0.z = cvt_pk_bf16(acc[4] * 0.125f, acc[5] * 0.125f); w0.w = cvt_pk_bf16(acc[6] * 0.125f, acc[7] * 0.125f);
        w1.x = cvt_pk_bf16(acc[8] * 0.125f, acc[9] * 0.125f); w1.y = cvt_pk_bf16(acc[10] * 0.125f, acc[11] * 0.125f); w1.z = cvt_pk_bf16(acc[12] * 0.125f, acc[13] * 0.125f); w1.w = cvt_pk_bf16(acc[14] * 0.125f, acc[15] * 0.125f);
        *(u32x4*)dst = w0; *(u32x4*)(dst + 8) = w1;
    }
    __syncthreads();
}

constexpr int LDS_BYTES = 147456, MISC_OFF = 131072 + 320;
constexpr int NPH = 3 + NL * 10;
__global__ void __launch_bounds__(512, 2) fwd_kernel(Args a_unused) {
    extern __shared__ __attribute__((aligned(16))) unsigned char lds_raw[];
    LAS unsigned char* lds = (LAS unsigned char*)lds_raw;
    const int tid = threadIdx.x, G = gridDim.x, wg = blockIdx.x, wv = __builtin_amdgcn_readfirstlane(threadIdx.x >> 6);
    volatile LAS unsigned* MISC = (volatile LAS unsigned*)(lds + MISC_OFF);
    if (tid < 32) MISC[tid] = 0u;
    __syncthreads();
    XcdBarrier bar; bar.bar = nullptr; bar.x = 0; bar.st = nullptr;
    int lo, hi;
    { const Args& a = fresh_args(); unsigned* barw = (unsigned*)(a.ws + WS_CTL) + CW_BAR; bar.bar = barw; lo = a.ph_lo; hi = a.ph_hi;
      if (MK_N_LAUNCHES == 1) bar = xcd_barrier_post(barw, MISC + 8); }
#ifndef PHASE_MASK
#define PHASE_MASK 0xFFFFu
#endif
#define PM(j) (((PHASE_MASK) >> (j)) & 1)
#define IN(k) (lo <= (k) && (k) < hi)
#define SEAM(k) do { if (MK_N_LAUNCHES == 1 && IN((k) + 1)) { XcdBarrier b2_ = bar; asm volatile("" : "+s"(b2_.bar)); xcd_barrier(b2_, wv); } } while (0)
#ifndef MIX_MASK
#define MIX_MASK 7
#endif
#ifndef REP_MASK
#define REP_MASK 0
#endif
#define REPS(j) for (int rep_ = 0; rep_ < 1 + (((REP_MASK) >> (j)) & 1); ++rep_)
#define WSP(T, off) ((T*)(a.ws + (off)))
#define WLP(off) ((const bf16*)(a.ws + WS_W + (size_t)l * WL_STRIDE + (off)))

    if (PM(10) && IN(0)) { REPS(10) { const Args& a = fresh_args(); ph_ada(a, lds, G, wg, wv); __syncthreads(); ph_weights(a, lds, G, wg, wv); } SEAM(0); }
    if (PM(11) && IN(1)) { const Args& a = fresh_args(); ph_ln<0>(a, 0, false, lds, G, wg, wv); SEAM(1); }
#pragma unroll 1
    for (int l = 0; l < NL; ++l) {
        const bool last = (l == NL - 1); const int pb = 3 + l * 10; const int npan = last ? 64 : 72;
        if (PM(0) && IN(pb + 0)) {
            const Args& a = fresh_args();
            SchedIn S{WSP(const bf16, WS_HL), WLP(WL_IN), G, wg, last};
            EpiIn E{WSP(bf16, WS_R1), WSP(bf16, WS_ZT), WSP(const float, WS_ROPE), WSP(const float, WS_ROPE) + 2048 * 32};
            REPS(0) gemm_phase(lds, S, E, wv); SEAM(pb + 0);
        }
        if (PM(1) && IN(pb + 1)) {
            if (MIX_MASK & 1) REPS(12) {
                const Args& a = fresh_args();
                const float lam = WSP(const float, WS_LAM)[l]; const float osc = 1.0f - (0.8f - 0.6f * expf(-0.3f * (float)l));
                const float* subg = a.in[I_SUBLN] + l * 128;
                const bf16* Zb = WSP(const bf16, WS_R1); float* O1b = WSP(float, WS_R2); bf16* Yb = WSP(bf16, WS_Y);
                const int nun = last ? 256 : 288;
                for (int u = wg; u < nun; u += G) {
                    int qrow0, crow0, lrow0, nt, h;
                    if (u < 256) { const int b = u >> 5; h = (u >> 3) & 3; qrow0 = b * 2048 + (u & 7) * 256; crow0 = RL + b * 256; lrow0 = b * 2048; nt = 36; }
                    else { const int q = u - 256, b = q >> 2; h = q & 3; qrow0 = RL + b * 256; crow0 = qrow0; lrow0 = 0; nt = 4; }
                    attn_pass<0>(Zb, O1b, qrow0, crow0, lrow0, 4, nt, h, (LAS char*)lds, wv);
                    attn_pass<1>(Zb, O1b, qrow0, crow0, lrow0, 4, nt, h, (LAS char*)lds, wv);
                    attn_combine(O1b, Yb, qrow0, h, lam, osc, subg, wv);
                }
                __syncthreads();
            }
            if (MIX_MASK & 2) { const Args& a = fresh_args(); SchedFourier S{WSP(const bf16, WS_FLAT), WSP(const bf16, WS_FCTX), WSP(const bf16, WS_ZT), G, (wg + 128) % G, last}; EpiStoreBf16 E{WSP(bf16, WS_Y), YC}; REPS(13) gemm_phase(lds, S, E, wv); }
            __syncthreads();
            if (MIX_MASK & 4) REPS(14) { const Args& a = fresh_args(); ph_prep(a, l, last, lds, G, (wg + 64) % G, wv); }
            SEAM(pb + 1);
        }
        if (PM(2) && IN(pb + 2)) { const Args& a = fresh_args(); SchedP S{WSP(const bf16, WS_Y), WLP(WL_P), G, wg, npan}; EpiStoreBf16 E{WSP(bf16, WS_R2), PC}; REPS(2) gemm_phase(lds, S, E, wv); SEAM(pb + 2); }
        if (PM(3) && IN(pb + 3)) { const Args& a = fresh_args(); SchedGate S{WSP(const bf16, WS_HL), WLP(WL_G), G, wg, npan}; EpiGate E{WSP(const bf16, WS_R2), WSP(bf16, WS_R1), a.in[I_BGATE] + l * 4096}; REPS(3) gemm_phase(lds, S, E, wv); SEAM(pb + 3); }
        if (PM(4) && IN(pb + 4)) { const Args& a = fresh_args(); SchedWo S{WSP(const bf16, WS_R1), WLP(WL_O), G, wg, npan}; EpiF32 E{WSP(float, WS_R2), D}; REPS(4) gemm_phase(lds, S, E, wv); SEAM(pb + 4); }
        if (PM(5) && IN(pb + 5)) { const Args& a = fresh_args(); ph_ln<1>(a, l, last, lds, G, wg, wv); SEAM(pb + 5); }
        if (PM(6) && IN(pb + 6)) { const Args& a = fresh_args(); REPS(6) ph_topk(a, last, lds, G, wg, wv); SEAM(pb + 6); }
        if (PM(7) && IN(pb + 7)) { const Args& a = fresh_args(); SchedE1 S{WSP(const bf16, WS_HL), WLP(WL_GU), WSP(const int, WS_IDX), G, wg, last ? 128 : 144}; EpiSwiglu E{WSP(bf16, WS_R1)}; REPS(7) gemm_phase(lds, S, E, wv); SEAM(pb + 7); }
        if (PM(8) && IN(pb + 8)) { const Args& a = fresh_args(); SchedE2 S{WSP(const bf16, WS_R1), WLP(WL_D), G, wg, last ? 128 : 144}; EpiDown E{WSP(bf16, WS_R2 + 72 * MiB), WSP(const float, WS_GV)}; REPS(8) gemm_phase(lds, S, E, wv); SEAM(pb + 8); }
        if (PM(9) && IN(pb + 9)) { const Args& a = fresh_args(); ph_ln<2>(a, l, last, lds, G, wg, wv); if (!last) SEAM(pb + 9); }
    }
#undef IN
#undef SEAM
}

extern "C" void kernel_launch(void* const* d_in, const int* in_sizes, int n_in, void* d_out, int out_size, void* d_ws, size_t ws_size, hipStream_t stream) {
    static int grid = 0;
    if (grid == 0) {
        if (n_in != 32 || in_sizes[0] != RL * D || out_size != RL * D || ws_size < WS_END) { fprintf(stderr, "kernel_launch: unexpected shapes (n_in %d, in0 %d, out %d, ws %zu < %zu)\n", n_in, n_in > 0 ? in_sizes[0] : -1, out_size, ws_size, (size_t)WS_END); grid = -1; return; }
        int dev = 0, cus = 0, per_cu = 0;
        if (hipGetDevice(&dev) != hipSuccess || hipDeviceGetAttribute(&cus, hipDeviceAttributeMultiprocessorCount, dev) != hipSuccess) { grid = -1; return; }
        if (hipFuncSetAttribute((const void*)fwd_kernel, hipFuncAttributeMaxDynamicSharedMemorySize, LDS_BYTES) != hipSuccess) { fprintf(stderr, "kernel_launch: hipFuncSetAttribute failed\n"); grid = -1; return; }
        if (hipOccupancyMaxActiveBlocksPerMultiprocessor(&per_cu, (const void*)fwd_kernel, 512, LDS_BYTES) != hipSuccess || per_cu < 1) fprintf(stderr, "kernel_launch: occupancy query says %d\n", per_cu);
        (void)hipGetLastError();
        grid = cus;
    }
    if (grid < 0) return;
    if (hipMemsetAsync((char*)d_ws + WS_CTL, 0, CTL_ZERO_BYTES, stream) != hipSuccess) return;
    Args a{};
    for (int i = 0; i < 32; ++i) a.in[i] = (const float*)d_in[i];
    a.out = (float*)d_out; a.ws = (unsigned char*)d_ws;
#if MK_N_LAUNCHES == 1
    a.ph_lo = 0; a.ph_hi = NPH;
    hipLaunchKernelGGL(fwd_kernel, dim3(grid), dim3(512), LDS_BYTES, stream, a);
#else
    for (int p = 0; p < NPH; ++p) { if (p == 2) continue; a.ph_lo = p; a.ph_hi = p + 1; hipLaunchKernelGGL(fwd_kernel, dim3(grid), dim3(512), LDS_BYTES, stream, a); }
#endif
    const hipError_t le = hipPeekAtLastError();
    if (le != hipSuccess) fprintf(stderr, "kernel_launch: launch failed: %s\n", hipGetErrorName(le));
}
```

```cpp
#include <hip/hip_runtime.h>
#include <cstdio>
#include <cstdint>

#ifndef MK_N_LAUNCHES
#define MK_N_LAUNCHES 1
#endif
#ifndef GEMM_FAST
#define GEMM_FAST 0
#endif

#define GAS __attribute__((address_space(1)))
#define LAS __attribute__((address_space(3)))
typedef unsigned short bf16;
typedef short bf16x8 __attribute__((ext_vector_type(8)));
typedef short s16x4 __attribute__((ext_vector_type(4)));
typedef float f32x4 __attribute__((ext_vector_type(4)));
typedef float f32x2 __attribute__((ext_vector_type(2)));
typedef float f32x16 __attribute__((ext_vector_type(16)));
typedef unsigned u32x4 __attribute__((ext_vector_type(4)));
typedef unsigned u32x2 __attribute__((ext_vector_type(2)));

constexpr int D = 1024, NB = 8, SEQ = 2048, CTXL = 256, NL = 4;
constexpr int RL = NB * SEQ, RC = NB * CTXL, R = RL + RC;
constexpr int ZC = 3328, YC = 2048, PC = 4096, MC = 1024;
constexpr int NE = 16, CAPL = 256, CAPC = 32;
constexpr int HROWS = NE * NB * CAPL + NE * NB * CAPC;
constexpr float LN_EPS = 1e-5f, RMS_EPS = 1e-5f, DN_ALPHA = 1.6817928305074290f;

constexpr size_t MiB = 1u << 20;
constexpr size_t WS_CTL = 0, CTL_ZERO_BYTES = 1 * MiB;
constexpr size_t WS_ADA = 1 * MiB;
constexpr size_t WS_LAM = 2 * MiB;
constexpr size_t WS_WSPB = 2 * MiB + 4096;
constexpr size_t WS_ROPE = 3 * MiB;
constexpr size_t WS_FCTX = 4 * MiB;
constexpr size_t WS_AFF = 5 * MiB;
constexpr size_t WS_IDX = 7 * MiB;
constexpr size_t WS_GV = 7 * MiB + 512 * 1024;
constexpr size_t WS_INV = 8 * MiB;
constexpr size_t WS_FLAT = 10 * MiB;
constexpr size_t WS_ZT = 26 * MiB;
constexpr size_t WS_X = 44 * MiB;
constexpr size_t WS_HL = 116 * MiB;
constexpr size_t WS_Y = 152 * MiB;
constexpr size_t WS_R1 = 224 * MiB;
constexpr size_t WS_R2 = 341 * MiB;
constexpr size_t WS_W = 485 * MiB;
constexpr size_t WL_IN = 0, WL_G = 7 * MiB, WL_P = 15 * MiB, WL_O = 23 * MiB, WL_GU = 25 * MiB, WL_D = 89 * MiB, WL_STRIDE = 121 * MiB;
constexpr size_t WS_END = WS_W + 4 * WL_STRIDE;
constexpr int CW_BAR = 4096;

__device__ __forceinline__ unsigned cvt_pk_bf16(float lo, float hi) { unsigned r; asm volatile("v_cvt_pk_bf16_f32 %0, %1, %2" : "=v"(r) : "v"(lo), "v"(hi)); return r; }
__device__ __forceinline__ float bf2f(unsigned short b) { return __uint_as_float((unsigned)b << 16); }
__device__ __forceinline__ float bflo(unsigned w) { return __uint_as_float(w << 16); }
__device__ __forceinline__ float bfhi(unsigned w) { return __uint_as_float(w & 0xffff0000u); }
__device__ __forceinline__ unsigned short f2bf(float f) { return (unsigned short)(cvt_pk_bf16(f, 0.f) & 0xffffu); }
__device__ __forceinline__ float wave_sum(float v) {
#pragma unroll
    for (int o = 1; o < 64; o <<= 1) v += __shfl_xor(v, o);
    return v;
}
__device__ __forceinline__ int wave_sum_i(int v) {
#pragma unroll
    for (int o = 1; o < 64; o <<= 1) v += __shfl_xor(v, o);
    return v;
}
__device__ __forceinline__ float sigmoid_f(float x) { return __builtin_amdgcn_rcpf(1.f + __expf(-x)); }
__device__ __forceinline__ float gelu_tanh(float x) { const float y = 0.7978845608028654f * (x + 0.044715f * x * x * x); return x * sigmoid_f(2.f * y); }
#define LDS_WAIT() asm volatile("s_waitcnt lgkmcnt(0)" ::: "memory")
#define VM_WAIT() asm volatile("s_waitcnt vmcnt(0)" ::: "memory")

__device__ __forceinline__ int tid_opaque(int wv) { unsigned z = 0u; asm volatile("" : "+v"(z)); return wv * 64 + (int)__builtin_amdgcn_mbcnt_hi(~0u, __builtin_amdgcn_mbcnt_lo(~0u, z)); }
#define XB_TMO      128
#define XB_XCNT(j)  (256  + 64 * (j))
#define XB_XSUB(j)  (1280 + 64 * (j))
#define XB_XGEN(j)  (2304 + 64 * (j))
#define XB_TOP      3328
#define XB_TOPGEN   3392
#define XCD_BAR_WORDS 3456
#define XB_SPIN_CAP (1u << 22)
__device__ __forceinline__ unsigned xb_ld(unsigned* p)              { return __hip_atomic_load(p, __ATOMIC_RELAXED, __HIP_MEMORY_SCOPE_AGENT); }
__device__ __forceinline__ unsigned xb_add(unsigned* p, unsigned v) { return __hip_atomic_fetch_add(p, v, __ATOMIC_RELAXED, __HIP_MEMORY_SCOPE_AGENT); }
__device__ __forceinline__ unsigned xb_xcc_id() { return (unsigned)__builtin_amdgcn_s_getreg((3 << 11) | 20) & 0xFu; }
#define XB_SPIN(cond, bar) do { unsigned _sp = 0; while (cond) { __builtin_amdgcn_s_sleep(1); \
    if ((++_sp & 255u) == 0u) { if (xb_ld(&(bar)[XB_TMO])) break; if (_sp > XB_SPIN_CAP) { atomicAdd(&(bar)[XB_TMO], 1u); break; } } } } while (0)
struct XcdBarrier { unsigned* bar; unsigned x; volatile LAS unsigned* st; };
__device__ __forceinline__ XcdBarrier xcd_barrier_post(unsigned* bar, volatile LAS unsigned* st) {
    XcdBarrier b; b.bar = bar; b.x = xb_xcc_id(); b.st = st;
    if (threadIdx.x == 0) (void)xb_add(&bar[XB_XCNT(b.x)], 1u);
    return b;
}
__device__ __forceinline__ void xcd_barrier_complete(unsigned* bar, unsigned x, unsigned& nloc, unsigned& nx) {
    const unsigned G = gridDim.x * gridDim.y * gridDim.z;
    unsigned sum, cnt, mine, sp = 0u;
    for (;;) {
        sum = 0u; cnt = 0u; mine = 0u;
#pragma unroll
        for (unsigned j = 0; j < 16; ++j) { const unsigned c = xb_ld(&bar[XB_XCNT(j)]); sum += c; cnt += (c > 0u) ? 1u : 0u; mine = (j == x) ? c : mine; }
        if (sum == G) break;
        __builtin_amdgcn_s_sleep(1);
        if ((++sp & 255u) == 0u) { if (xb_ld(&bar[XB_TMO])) break; if (sp > XB_SPIN_CAP) { atomicAdd(&bar[XB_TMO], 1u); break; } }
    }
    nloc = mine > 0u ? mine : 1u; nx = cnt > 0u ? cnt : 1u;
}
__device__ __forceinline__ void xcd_barrier(const XcdBarrier& b, int wv) {
    asm volatile("s_waitcnt vmcnt(0)" ::: "memory");
    __syncthreads();
    if (tid_opaque(wv) == 0) {
        unsigned* bar = b.bar;
        __builtin_amdgcn_s_waitcnt(0);
        unsigned nloc = b.st[0], nx = b.st[1];
        if (nloc == 0u) { xcd_barrier_complete(bar, b.x, nloc, nx); b.st[0] = nloc; b.st[1] = nx; }
        const unsigned old = xb_add(&bar[XB_XSUB(b.x)], 1u);
        const unsigned gen = old / nloc;
        if (old + 1u == (gen + 1u) * nloc) {
            __builtin_amdgcn_fence(__ATOMIC_RELEASE, "agent");
            asm volatile("s_waitcnt vmcnt(0)" ::: "memory");
            const unsigned og = xb_add(&bar[XB_TOP], 1u);
            const unsigned tg = og / nx;
            if (og + 1u == (tg + 1u) * nx) xb_add(&bar[XB_TOPGEN], 1u);
            else XB_SPIN(xb_ld(&bar[XB_TOPGEN]) == tg, bar);
            __builtin_amdgcn_fence(__ATOMIC_ACQUIRE, "agent");
            xb_add(&bar[XB_XGEN(b.x)], 1u);
            asm volatile("s_waitcnt vmcnt(0)" ::: "memory");
        } else {
            XB_SPIN(xb_ld(&bar[XB_XGEN(b.x)]) == gen, bar);
            __builtin_amdgcn_fence(__ATOMIC_ACQUIRE, "agent");
            asm volatile("s_waitcnt vmcnt(0)" ::: "memory");
        }
    }
    __syncthreads();
}

struct Args { const float* in[32]; float* out; unsigned char* ws; int ph_lo, ph_hi; };
enum { I_X = 0, I_C, I_CTX, I_CCTX, I_WADA, I_BADA, I_WIN, I_WGATE, I_BGATE, I_SGUG, I_SGUB, I_WSP, I_BSP, I_CONVW, I_LQ1, I_LK1, I_LQ2, I_LK2, I_SUBLN,
       I_WPA, I_WPB, I_WPC, I_WPD, I_WO, I_LN1G, I_LN1B, I_WROUTER, I_WEG, I_WEU, I_WED, I_LN2G, I_LN2B };

__device__ __forceinline__ const Args& fresh_args() { auto p = (const __attribute__((address_space(4))) Args*)__builtin_amdgcn_kernarg_segment_ptr(); asm volatile("" : "+s"(p)); return *(const Args*)p; }
struct Unit { const bf16* A; const bf16* B; const int* gidx; int lda, ldb, K, pm, pn, aux; };
__device__ __forceinline__ int perm32(int rho) { const int n = rho >> 4, i = rho & 15; return 8 * (i >> 2) + 4 * n + (i & 3); }

template <class Epi, class Sched>
__device__ __forceinline__ void gemm_phase_simple(LAS unsigned char* lds, const Sched& S, const Epi& E, int wv) {
    const int tid = tid_opaque(wv), wid = __builtin_amdgcn_readfirstlane(tid >> 6), lane = tid & 63, wr = wid >> 2, wc = wid & 3, fr = lane & 15, fq = lane >> 4;
    Unit u;
    for (int i = 0; S.next(i, u); ++i) {
        f32x4 acc[2][2][4][2];
#pragma unroll
        for (int a = 0; a < 2; ++a)
#pragma unroll
            for (int b = 0; b < 2; ++b)
#pragma unroll
                for (int m = 0; m < 4; ++m)
#pragma unroll
                    for (int n = 0; n < 2; ++n) acc[a][b][m][n] = (f32x4){0.f, 0.f, 0.f, 0.f};
        unsigned ao[2][4], bo[2][2];
#pragma unroll
        for (int ai = 0; ai < 2; ++ai)
#pragma unroll
            for (int m = 0; m < 4; ++m) { const int r = ai * 128 + wr * 64 + m * 16 + fr; const unsigned gr = u.gidx ? (unsigned)u.gidx[r] : (unsigned)r; ao[ai][m] = gr * (unsigned)u.lda + fq * 8; }
#pragma unroll
        for (int bj = 0; bj < 2; ++bj)
#pragma unroll
            for (int n = 0; n < 2; ++n) { const int slot = n * 16 + fr; const int rr = Epi::PERM ? perm32(slot) : slot; bo[bj][n] = (unsigned)(bj * 128 + wc * 32 + rr) * (unsigned)u.ldb + fq * 8; }
        for (int k0 = 0; k0 < u.K; k0 += 64) {
#pragma unroll
            for (int ai = 0; ai < 2; ++ai) {
                bf16x8 At[4][2];
#pragma unroll
                for (int m = 0; m < 4; ++m)
#pragma unroll
                    for (int k = 0; k < 2; ++k) At[m][k] = *(const bf16x8*)(u.A + k0 + k * 32 + ao[ai][m]);
#pragma unroll
                for (int bj = 0; bj < 2; ++bj) {
                    bf16x8 Bf[2][2];
#pragma unroll
                    for (int n = 0; n < 2; ++n)
#pragma unroll
                        for (int k = 0; k < 2; ++k) Bf[n][k] = *(const bf16x8*)(u.B + k0 + k * 32 + bo[bj][n]);
#pragma unroll
                    for (int m = 0; m < 4; ++m)
#pragma unroll
                        for (int n = 0; n < 2; ++n)
#pragma unroll
                            for (int k = 0; k < 2; ++k) acc[ai][bj][m][n] = __builtin_amdgcn_mfma_f32_16x16x32_bf16(Bf[n][k], At[m][k], acc[ai][bj][m][n], 0, 0, 0);
                }
            }
        }
        E(acc, u, wr, wc, fr, fq);
    }
}


constexpr int HTB = 128 * 64 * 2, GATHER_OFF = 131072 + 1024;
__device__ __forceinline__ int lds_byte(int r, int c) { const int st = (r >> 4) * 2 + (c >> 5), rr = r & 15, cc = c & 31, ob = rr * 64 + cc * 2; return st * 1024 + (ob ^ (((ob >> 9) & 1) << 5)); }
__device__ __forceinline__ void stage_rc(int b, int& Rr, int& Cc) { const int st = b / 1024, sb = b % 1024, swz = sb ^ (((sb >> 9) & 1) << 5); Rr = (st >> 1) * 16 + swz / 64; Cc = (st & 1) * 32 + (swz % 64) / 2; }
template <class Epi, class Sched>
__device__ __forceinline__ void gemm_phase(LAS unsigned char* lds, const Sched& S, const Epi& E, int wv) {
    const int tid = tid_opaque(wv), wid = __builtin_amdgcn_readfirstlane(tid >> 6), lane = tid & 63, wr = wid >> 2, wc = wid & 3, fr = lane & 15, fq = lane >> 4;
    Unit cur, nxt; int ui = 0;
    if (!S.next(0, cur)) return;
    if (Sched::GATHER) {
        LAS int* gl = (LAS int*)(lds + GATHER_OFF);
        Unit t_;
        for (int i = 0; S.next(i, t_); ++i) if (tid < 256) gl[i * 256 + tid] = t_.gidx[tid];
        __syncthreads();
    }
    int sR[2], sC[2], sRb[2];
#pragma unroll
    for (int i = 0; i < 2; ++i) { int Rr, Cc; stage_rc(tid * 16 + i * 8192, Rr, Cc); sR[i] = Rr; sC[i] = Cc; sRb[i] = Epi::PERM ? ((Rr & ~31) + perm32(Rr & 31)) : Rr; }
    const unsigned ldsw = (unsigned)wid * 1024u;
    const int aoff = lds_byte(wr * 64 + fr, fq * 8), boff = lds_byte(wc * 32 + fr, fq * 8);
    unsigned vA[2][2], vB[2]; size_t hB;
#define G_OFFS(u_, ui_) do { _Pragma("unroll") for (int h_ = 0; h_ < 2; ++h_) _Pragma("unroll") for (int i_ = 0; i_ < 2; ++i_) { const int r_ = h_ * 128 + sR[i_]; \
        const unsigned gr_ = Sched::GATHER ? (unsigned)((LAS int*)(lds + GATHER_OFF))[(ui_) * 256 + r_] : (unsigned)r_; vA[h_][i_] = (gr_ * (unsigned)(u_).lda + (unsigned)sC[i_]) * 2u; } \
        _Pragma("unroll") for (int i_ = 0; i_ < 2; ++i_) vB[i_] = ((unsigned)sRb[i_] * (unsigned)(u_).ldb + (unsigned)sC[i_]) * 2u; hB = (size_t)(u_).ldb * 256; } while (0)
#define G_SA(b, h) (((b) * 2 + (h)) * HTB)
#define G_SB(b, h) ((4 + (b) * 2 + (h)) * HTB)
#define G_STAGE(bufoff, gbase, voff) do { _Pragma("unroll") for (int _i = 0; _i < 2; ++_i) \
        __builtin_amdgcn_global_load_lds((const unsigned*)((const char*)(gbase) + (voff)[_i]), (LAS unsigned*)(lds + (bufoff) + ldsw + _i * 8192), 16, 0, 0); } while (0)
#define G_LDA(dst, b, h) do { _Pragma("unroll") for (int m = 0; m < 4; ++m) _Pragma("unroll") for (int k = 0; k < 2; ++k) dst[m][k] = *(const LAS bf16x8*)(lds + G_SA(b, h) + aoff + m * 2048 + k * 1024); } while (0)
#define G_LDB(dst, b, h) do { _Pragma("unroll") for (int n = 0; n < 2; ++n) _Pragma("unroll") for (int k = 0; k < 2; ++k) dst[n][k] = *(const LAS bf16x8*)(lds + G_SB(b, h) + boff + n * 2048 + k * 1024); } while (0)
#define G_MMA(ai, bj, At_, Bt_) do { __builtin_amdgcn_s_setprio(1); _Pragma("unroll") for (int m = 0; m < 4; ++m) _Pragma("unroll") for (int n = 0; n < 2; ++n) _Pragma("unroll") for (int k = 0; k < 2; ++k) \
        acc[ai][bj][m][n] = __builtin_amdgcn_mfma_f32_16x16x32_bf16(Bt_[n][k], At_[m][k], acc[ai][bj][m][n], 0, 0, 0); __builtin_amdgcn_s_setprio(0); } while (0)
#define G_WAIT_V(n) asm volatile("s_waitcnt vmcnt(" #n ")" ::: "memory")
#define G_WAIT_L(n) asm volatile("s_waitcnt lgkmcnt(" #n ")" ::: "memory")
#define G_BAR __builtin_amdgcn_s_barrier()
#define G_SCHED __builtin_amdgcn_sched_barrier(0)
    f32x4 acc[2][2][4][2];
#pragma unroll
    for (int a = 0; a < 2; ++a)
#pragma unroll
        for (int b = 0; b < 2; ++b)
#pragma unroll
            for (int m = 0; m < 4; ++m)
#pragma unroll
                for (int n = 0; n < 2; ++n) acc[a][b][m][n] = (f32x4){0.f, 0.f, 0.f, 0.f};
    bf16x8 At[4][2], B0[2][2], B1[2][2];
    const char* cA = (const char*)cur.A; const char* cB = (const char*)cur.B;
    const size_t kstep = 128;
    G_OFFS(cur, 0);
    G_STAGE(G_SB(0, 0), cB, vB); G_STAGE(G_SB(0, 1), cB + hB, vB); G_STAGE(G_SA(0, 0), cA, vA[0]); G_STAGE(G_SA(0, 1), cA, vA[1]);
    if (wr == 1) G_BAR;
    G_WAIT_V(2); G_BAR;
    G_STAGE(G_SB(1, 0), cB + kstep, vB); G_STAGE(G_SA(1, 0), cA + kstep, vA[0]); G_STAGE(G_SB(1, 1), cB + hB + kstep, vB);
    G_WAIT_V(6); G_BAR;
    for (;;) {
        const bool has_next = S.next(ui + 1, nxt);
        const char* nA = has_next ? (const char*)nxt.A : cA; const char* nB = has_next ? (const char*)nxt.B : cB;
        const int nt = cur.K >> 6;
        for (int t = 0; t < nt; t += 2) {
            const bool last = (t == nt - 2);
            const char* a1 = cA + (size_t)(t + 1) * kstep;
            const char* a2 = last ? nA : cA + (size_t)(t + 2) * kstep; const char* b2 = last ? nB : cB + (size_t)(t + 2) * kstep;
            const char* a3 = a2 + kstep; const char* b3 = b2 + kstep;
            G_LDB(B0, 0, 0); G_LDB(B1, 0, 1); G_SCHED; G_LDA(At, 0, 0); G_STAGE(G_SA(1, 1), a1, vA[1]);
            if (last && has_next) G_OFFS(nxt, ui + 1);
            G_WAIT_V(8); G_WAIT_L(0); G_BAR; G_MMA(0, 0, At, B0); G_MMA(0, 1, At, B1); G_BAR; G_SCHED;
            G_LDA(At, 0, 1); G_STAGE(G_SB(0, 0), b2, vB); G_STAGE(G_SB(0, 1), b2 + hB, vB); G_STAGE(G_SA(0, 0), a2, vA[0]);
            G_WAIT_V(8); G_WAIT_L(0); G_BAR; G_MMA(1, 0, At, B0); G_MMA(1, 1, At, B1); G_BAR; G_SCHED;
            G_LDB(B0, 1, 0); G_LDB(B1, 1, 1); G_SCHED; G_LDA(At, 1, 0); G_STAGE(G_SA(0, 1), a2, vA[1]);
            G_WAIT_V(8); G_WAIT_L(0); G_BAR; G_MMA(0, 0, At, B0); G_MMA(0, 1, At, B1); G_BAR; G_SCHED;
            G_LDA(At, 1, 1); G_STAGE(G_SB(1, 0), b3, vB); G_STAGE(G_SB(1, 1), b3 + hB, vB); G_STAGE(G_SA(1, 0), a3, vA[0]);
            G_WAIT_V(8); G_WAIT_L(0); G_BAR; G_MMA(1, 0, At, B0); G_MMA(1, 1, At, B1); G_BAR; G_SCHED;
        }
        if (wr == 0) G_BAR;
        E(acc, cur, wr, wc, fr, fq);
        if (!has_next) break;
#pragma unroll
        for (int a = 0; a < 2; ++a)
#pragma unroll
            for (int b = 0; b < 2; ++b)
#pragma unroll
                for (int m = 0; m < 4; ++m)
#pragma unroll
                    for (int n = 0; n < 2; ++n) acc[a][b][m][n] = (f32x4){0.f, 0.f, 0.f, 0.f};
        cur = nxt; cA = nA; cB = nB; ++ui;
        if (wr == 1) G_BAR;
    }
    G_WAIT_V(0);
    G_BAR;
#undef G_OFFS
#undef G_SA
#undef G_SB
#undef G_STAGE
#undef G_LDA
#undef G_LDB
#undef G_MMA
#undef G_WAIT_V
#undef G_WAIT_L
#undef G_BAR
#undef G_SCHED
}

#define EPI_ROWS_BEGIN _Pragma("unroll") for (int ai = 0; ai < 2; ++ai) _Pragma("unroll") for (int m = 0; m < 4; ++m) { const int rl = ai * 128 + wr * 64 + m * 16 + fr;
#define EPI_ROWS_END }
__device__ __forceinline__ u32x4 pack8(const f32x4 a, const f32x4 b) { u32x4 w; w.x = cvt_pk_bf16(a[0], a[1]); w.y = cvt_pk_bf16(a[2], a[3]); w.z = cvt_pk_bf16(b[0], b[1]); w.w = cvt_pk_bf16(b[2], b[3]); return w; }
__device__ __forceinline__ void unpack8(const u32x4 w, float (&f)[8]) { f[0] = bflo(w.x); f[1] = bfhi(w.x); f[2] = bflo(w.y); f[3] = bfhi(w.y); f[4] = bflo(w.z); f[5] = bfhi(w.z); f[6] = bflo(w.w); f[7] = bfhi(w.w); }

struct EpiIn {
    static constexpr bool PERM = true;
    bf16* Z; bf16* ZT; const float* ropec; const float* ropes;
    __device__ __forceinline__ void operator()(const f32x4 (&acc)[2][2][4][2], const Unit& u, int wr, int wc, int fr, int fq) const {
        const int pn = u.pn; const bool lat = u.pm < 64;
        EPI_ROWS_BEGIN
            const int row = u.pm * 256 + rl;
#pragma unroll
            for (int bj = 0; bj < 2; ++bj) {
                const int col0 = pn * 256 + bj * 128 + wc * 32 + 8 * fq;
                f32x4 v0 = acc[ai][bj][m][0], v1 = acc[ai][bj][m][1];
                if (pn < 2) {
#pragma unroll
                    for (int j = 0; j < 4; ++j) { v0[j] = gelu_tanh(v0[j]); v1[j] = gelu_tanh(v1[j]); }
                } else if (pn >= 5 && pn <= 8 && lat) {
                    const int t = row & 2047, p0 = (col0 & 63) >> 1;
                    const f32x4 cs = *(const f32x4*)(ropec + t * 32 + p0), sn = *(const f32x4*)(ropes + t * 32 + p0);
                    const f32x4 a = v0, b = v1;
                    v0[0] = a[0] * cs[0] - a[1] * sn[0]; v0[1] = a[0] * sn[0] + a[1] * cs[0];
                    v0[2] = a[2] * cs[1] - a[3] * sn[1]; v0[3] = a[2] * sn[1] + a[3] * cs[1];
                    v1[0] = b[0] * cs[2] - b[1] * sn[2]; v1[1] = b[0] * sn[2] + b[1] * cs[2];
                    v1[2] = b[2] * cs[3] - b[3] * sn[3]; v1[3] = b[2] * sn[3] + b[3] * cs[3];
                }
                if (pn < 11) {
                    *(u32x4*)(Z + (size_t)row * ZC + col0) = pack8(v0, v1);
                } else {
                    const int cc = col0 - pn * 256;
#pragma unroll
                    for (int j = 0; j < 8; ++j) {
                        const float val = j < 4 ? v0[j & 3] : v1[j & 3];
                        size_t o;
                        if (lat) { const int b = row >> 11, n = row & 2047; o = ((size_t)(b * 256 + cc + j)) * 4096 + (pn == 12 ? 2048 : 0) + n; }
                        else { const int rc = row - RL, b = rc >> 8, n = rc & 255; o = (size_t)8 * 256 * 4096 + ((size_t)(b * 256 + cc + j)) * 512 + (pn == 12 ? 256 : 0) + n; }
                        ZT[o] = f2bf(val);
                    }
                }
            }
        EPI_ROWS_END
    }
};
struct EpiStoreBf16 {
    static constexpr bool PERM = true;
    bf16* O; int ldc;
    __device__ __forceinline__ void operator()(const f32x4 (&acc)[2][2][4][2], const Unit& u, int wr, int wc, int fr, int fq) const {
        EPI_ROWS_BEGIN
#pragma unroll
            for (int bj = 0; bj < 2; ++bj) { const int col0 = u.pn * 256 + bj * 128 + wc * 32 + 8 * fq;
                *(u32x4*)(O + (size_t)(u.aux + rl) * ldc + col0) = pack8(acc[ai][bj][m][0], acc[ai][bj][m][1]); }
        EPI_ROWS_END
    }
};
struct EpiGate {
    static constexpr bool PERM = false;
    const bf16* P; bf16* M; const float* bgate;
    __device__ __forceinline__ void operator()(const f32x4 (&acc)[2][2][4][2], const Unit& u, int wr, int wc, int fr, int fq) const {
        const int cb = u.pn * 64 + wc * 16 + 4 * fq;
        f32x4 bias[2][2];
#pragma unroll
        for (int bj = 0; bj < 2; ++bj)
#pragma unroll
            for (int n = 0; n < 2; ++n) bias[bj][n] = *(const f32x4*)(bgate + (2 * bj + n) * 1024 + cb);
        EPI_ROWS_BEGIN
            const size_t row = (size_t)u.pm * 256 + rl;
            f32x4 o = {0.f, 0.f, 0.f, 0.f};
#pragma unroll
            for (int bj = 0; bj < 2; ++bj)
#pragma unroll
                for (int n = 0; n < 2; ++n) { const u32x2 pw = *(const u32x2*)(P + row * PC + (2 * bj + n) * 1024 + cb); const f32x4 x = acc[ai][bj][m][n] + bias[bj][n];
                    o[0] += sigmoid_f(x[0]) * bflo(pw.x); o[1] += sigmoid_f(x[1]) * bfhi(pw.x); o[2] += sigmoid_f(x[2]) * bflo(pw.y); o[3] += sigmoid_f(x[3]) * bfhi(pw.y); }
            u32x2 w; w.x = cvt_pk_bf16(o[0], o[1]); w.y = cvt_pk_bf16(o[2], o[3]);
            *(u32x2*)(M + row * MC + cb) = w;
        EPI_ROWS_END
    }
};
struct EpiF32 {
    static constexpr bool PERM = false;
    float* C; int ldc;
    __device__ __forceinline__ void operator()(const f32x4 (&acc)[2][2][4][2], const Unit& u, int wr, int wc, int fr, int fq) const {
        EPI_ROWS_BEGIN
            float* rowp = C + ((size_t)u.pm * 256 + rl) * ldc + u.pn * 256 + wc * 32 + 4 * fq;
#pragma unroll
            for (int bj = 0; bj < 2; ++bj)
#pragma unroll
                for (int n = 0; n < 2; ++n) *(f32x4*)(rowp + bj * 128 + n * 16) = acc[ai][bj][m][n];
        EPI_ROWS_END
    }
};
struct EpiSwiglu {
    static constexpr bool PERM = true;
    bf16* HID;
    __device__ __forceinline__ void operator()(const f32x4 (&acc)[2][2][4][2], const Unit& u, int wr, int wc, int fr, int fq) const {
        EPI_ROWS_BEGIN
            f32x4 o0, o1;
#pragma unroll
            for (int j = 0; j < 4; ++j) { const float g0 = acc[ai][0][m][0][j], g1 = acc[ai][0][m][1][j];
                o0[j] = g0 * sigmoid_f(g0) * acc[ai][1][m][0][j]; o1[j] = g1 * sigmoid_f(g1) * acc[ai][1][m][1][j]; }
            *(u32x4*)(HID + ((size_t)u.pm * 256 + rl) * 1024 + u.pn * 128 + wc * 32 + 8 * fq) = pack8(o0, o1);
        EPI_ROWS_END
    }
};
struct EpiDown {
    static constexpr bool PERM = true;
    bf16* YE; const float* GV;
    __device__ __forceinline__ void operator()(const f32x4 (&acc)[2][2][4][2], const Unit& u, int wr, int wc, int fr, int fq) const {
        EPI_ROWS_BEGIN
            const size_t row = (size_t)u.pm * 256 + rl; const float g = GV[row];
#pragma unroll
            for (int bj = 0; bj < 2; ++bj) *(u32x4*)(YE + row * 1024 + u.pn * 256 + bj * 128 + wc * 32 + 8 * fq) = pack8(acc[ai][bj][m][0] * g, acc[ai][bj][m][1] * g);
        EPI_ROWS_END
    }
};

struct SchedIn {
    static constexpr bool GATHER = false;
    const bf16* HL; const bf16* W; int G, c; bool last;
    __device__ __forceinline__ bool next(int i, Unit& u) const {
        const int idx = i * G + c; int pm, pn;
        if (!last) { if (idx >= 72 * 13) return false; pm = idx / 13; pn = idx % 13; }
        else { if (idx >= 64 * 13 + 32) return false; if (idx < 64 * 13) { pm = idx / 13; pn = idx % 13; } else { const int q = idx - 64 * 13; pm = 64 + (q >> 2); pn = 7 + (q & 3); } }
        u.A = HL + (size_t)pm * 256 * D; u.B = W + (size_t)pn * 256 * D; u.gidx = nullptr; u.lda = D; u.ldb = D; u.K = D; u.pm = pm; u.pn = pn; u.aux = 0; return true;
    }
};
struct SchedFourier {
    static constexpr bool GATHER = false;
    const bf16* FL; const bf16* FC; const bf16* ZT; int G, c; bool last;
    __device__ __forceinline__ bool next(int i, Unit& u) const {
        const int idx = i * G + c; if (idx >= (last ? 256 : 264)) return false;
        u.gidx = nullptr;
        if (idx < 256) { const int b = idx >> 5, pm = (idx >> 2) & 7, sq = idx & 3; u.A = FL + (size_t)pm * 256 * 4096 + sq * 1024; u.B = ZT + (size_t)b * 256 * 4096 + sq * 1024; u.lda = 4096; u.ldb = 4096; u.K = 1024; u.pm = idx; u.pn = 4 + sq; u.aux = b * 2048 + pm * 256; }
        else { const int b = idx - 256; u.A = FC; u.B = ZT + (size_t)8 * 256 * 4096 + (size_t)b * 256 * 512; u.lda = 512; u.ldb = 512; u.K = 512; u.pm = idx; u.pn = 4; u.aux = RL + b * 256; }
        return true;
    }
};
struct SchedP {
    static constexpr bool GATHER = false;
    const bf16* Y; const bf16* W; int G, c, npan;
    __device__ __forceinline__ bool next(int i, Unit& u) const {
        const int idx = i * G + c; if (idx >= npan * 16) return false;
        const int pm = idx >> 4, q = idx & 15, br = q >> 2, pnl = q & 3;
        const int coff = br == 0 ? 0 : (br == 1 ? 256 : (br == 2 ? 512 : 1024));
        u.A = Y + (size_t)pm * 256 * YC + coff; u.B = W + ((size_t)br * 1024 + pnl * 256) * 1024; u.gidx = nullptr; u.lda = YC; u.ldb = 1024; u.K = br == 2 ? 512 : (br == 3 && pm < 64 ? 1024 : 256); u.pm = pm; u.pn = q; u.aux = pm * 256; return true;
    }
};
struct SchedGate {
    static constexpr bool GATHER = false;
    const bf16* HL; const bf16* W; int G, c, npan;
    __device__ __forceinline__ bool next(int i, Unit& u) const {
        const int idx = i * G + c; if (idx >= npan * 16) return false;
        const int pm = idx >> 4, tn = idx & 15;
        u.A = HL + (size_t)pm * 256 * D; u.B = W + (size_t)tn * 256 * D; u.gidx = nullptr; u.lda = D; u.ldb = D; u.K = D; u.pm = pm; u.pn = tn; u.aux = 0; return true;
    }
};
struct SchedWo {
    static constexpr bool GATHER = false;
    const bf16* M2; const bf16* W; int G, c, npan;
    __device__ __forceinline__ bool next(int i, Unit& u) const {
        const int idx = i * G + c; if (idx >= npan * 4) return false;
        const int pm = idx >> 2, pn = idx & 3;
        u.A = M2 + (size_t)pm * 256 * MC; u.B = W + (size_t)pn * 256 * MC; u.gidx = nullptr; u.lda = MC; u.ldb = MC; u.K = MC; u.pm = pm; u.pn = pn; u.aux = 0; return true;
    }
};
struct SchedE1 {
    static constexpr bool GATHER = true;
    const bf16* HL; const bf16* W; const int* IDX; int G, c, npanel;
    __device__ __forceinline__ bool next(int i, Unit& u) const {
        const int idx = i * G + c; if (idx >= npanel * 8) return false;
        const int panel = idx >> 3, tn = idx & 7, e = panel < 128 ? (panel >> 3) : (panel - 128);
        u.A = HL; u.B = W + ((size_t)e * 2048 + tn * 256) * D; u.gidx = IDX + panel * 256; u.lda = D; u.ldb = D; u.K = D; u.pm = panel; u.pn = tn; u.aux = e; return true;
    }
};
struct SchedE2 {
    static constexpr bool GATHER = false;
    const bf16* HID; const bf16* W; int G, c, npanel;
    __device__ __forceinline__ bool next(int i, Unit& u) const {
        const int idx = i * G + c; if (idx >= npanel * 4) return false;
        const int panel = idx >> 2, pn = idx & 3, e = panel < 128 ? (panel >> 3) : (panel - 128);
        u.A = HID + (size_t)panel * 256 * 1024; u.B = W + ((size_t)e * 1024 + pn * 256) * 1024; u.gidx = nullptr; u.lda = 1024; u.ldb = 1024; u.K = 1024; u.pm = panel; u.pn = pn; u.aux = e; return true;
    }
};

constexpr int AT_SHM_V = 64 * 128 * 2, AT_SHM_K = 64 * 64 * 2;
#define KSWZ64(row, colB) ((row) * 128 + ((colB) ^ ((((row) >> 1) & 7) << 4)))
#define SBAR() __builtin_amdgcn_sched_barrier(0)
__device__ __forceinline__ int crow(int r, int hi) { return (r & 3) + 8 * (r >> 2) + 4 * hi; }
constexpr float AT_SCALE = 0.125f, AT_THR = 8.f;
__device__ __forceinline__ void partialSM(f32x16& p0, f32x16& p1, float& m_reg, float& mn, float& alpha) {
    constexpr float C = AT_SCALE * 1.4426950408889634f;
    float pmax = p0[0];
#pragma unroll
    for (int r = 1; r < 16; ++r) pmax = fmaxf(pmax, p0[r]);
#pragma unroll
    for (int r = 0; r < 16; ++r) pmax = fmaxf(pmax, p1[r]);
    { auto rr = __builtin_amdgcn_permlane32_swap(__float_as_uint(pmax), __float_as_uint(pmax), false, false);
      pmax = fmaxf(__uint_as_float(rr[0]), __uint_as_float(rr[1])); }
    if (__builtin_expect(__all(pmax - m_reg <= AT_THR / AT_SCALE), 1)) { mn = m_reg; alpha = 1.f; }
    else { mn = fmaxf(m_reg, pmax); alpha = __builtin_amdgcn_exp2f((m_reg - mn) * C); m_reg = mn; }
    const float mnC = -mn * C;
#pragma unroll
    for (int r = 0; r < 16; ++r) p0[r] = fmaf(p0[r], C, mnC);
#pragma unroll
    for (int r = 0; r < 16; ++r) p1[r] = fmaf(p1[r], C, mnC);
#pragma unroll
    for (int r = 0; r < 16; ++r) p0[r] = __builtin_amdgcn_exp2f(p0[r]);
}
__device__ __forceinline__ void finishSM(f32x16& p0, f32x16& p1, float alpha, float& l_reg, bf16x8& pa0, bf16x8& pa1, bf16x8& pa2, bf16x8& pa3) {
#pragma unroll
    for (int r = 0; r < 16; ++r) p1[r] = __builtin_amdgcn_exp2f(p1[r]);
    float ps = 0;
#pragma unroll
    for (int r = 0; r < 16; ++r) ps += p0[r];
#pragma unroll
    for (int r = 0; r < 16; ++r) ps += p1[r];
    { auto rr = __builtin_amdgcn_permlane32_swap(__float_as_uint(ps), __float_as_uint(ps), false, false);
      ps = __uint_as_float(rr[0]) + __uint_as_float(rr[1]); }
    l_reg = l_reg * alpha + ps;
#define PK4(P, BASE, OUT) do { unsigned a0 = cvt_pk_bf16(P[BASE + 0], P[BASE + 1]), a1 = cvt_pk_bf16(P[BASE + 2], P[BASE + 3]);   \
    unsigned b0 = cvt_pk_bf16(P[BASE + 4], P[BASE + 5]), b1 = cvt_pk_bf16(P[BASE + 6], P[BASE + 7]);                              \
    auto r0 = __builtin_amdgcn_permlane32_swap(a0, b0, false, false); auto r1 = __builtin_amdgcn_permlane32_swap(a1, b1, false, false); \
    u32x4 w = {r0[0], r1[0], r0[1], r1[1]}; OUT = *reinterpret_cast<bf16x8*>(&w); } while (0)
    PK4(p0, 0, pa0); PK4(p0, 8, pa1); PK4(p1, 0, pa2); PK4(p1, 8, pa3);
#undef PK4
}
__device__ __forceinline__ void qkt(f32x16& p0, f32x16& p1, const LAS char* Ks, const bf16x8 (&qr)[4], int r32, int hi) {
    p0 = f32x16{}; p1 = f32x16{};
#pragma unroll
    for (int d0 = 0; d0 < 4; ++d0) { const int cb = (d0 * 16 + hi * 8) * 2;
        const bf16x8 b0 = *(const LAS bf16x8*)(Ks + KSWZ64(r32, cb));
        const bf16x8 b1 = *(const LAS bf16x8*)(Ks + KSWZ64(32 + r32, cb));
        p0 = __builtin_amdgcn_mfma_f32_32x32x16_bf16(b0, qr[d0], p0, 0, 0, 0);
        p1 = __builtin_amdgcn_mfma_f32_32x32x16_bf16(b1, qr[d0], p1, 0, 0, 0); }
}
__device__ __forceinline__ int v_st(int k, int c) { const int kk = (k & ~0xC) | ((k & 4) << 1) | ((k & 8) >> 1); return ((kk >> 3) * 4 + (c >> 5)) * 512 + ((kk & 7) * 32 + (c & 31)) * 2; }
__device__ __forceinline__ int v_rd_base(int lane) { return ((lane & 3) << 3) | (((lane >> 2) & 3) << 6) | (((lane >> 4) & 1) << 5) | (((lane >> 5) & 1) << 8); }
constexpr int v_rd_off(int d0, int ks, int half) { return d0 * 512 + ks * 4096 + half * 2048; }
template <int OFF> __device__ __forceinline__ s16x4 tr_read(int vb) {
    s16x4 r; asm volatile("ds_read_b64_tr_b16 %0, %1 offset:%2" : "=&v"(r) : "v"(vb), "i"(OFF) : "memory"); return r;
}
template <int D0> __device__ __forceinline__ void pv_one(f32x16& od, int vb, bf16x8 pa0, bf16x8 pa1, bf16x8 pa2, bf16x8 pa3) {
    const s16x4 l0 = tr_read<v_rd_off(D0, 0, 0)>(vb), h0 = tr_read<v_rd_off(D0, 0, 1)>(vb), l1 = tr_read<v_rd_off(D0, 1, 0)>(vb), h1 = tr_read<v_rd_off(D0, 1, 1)>(vb);
    const s16x4 l2 = tr_read<v_rd_off(D0, 2, 0)>(vb), h2 = tr_read<v_rd_off(D0, 2, 1)>(vb), l3 = tr_read<v_rd_off(D0, 3, 0)>(vb), h3 = tr_read<v_rd_off(D0, 3, 1)>(vb);
    asm volatile("s_waitcnt lgkmcnt(0)" ::: "memory"); SBAR();
#define PK(L, H) (bf16x8){L[0], L[1], L[2], L[3], H[0], H[1], H[2], H[3]}
    od = __builtin_amdgcn_mfma_f32_32x32x16_bf16(pa0, PK(l0, h0), od, 0, 0, 0);
    od = __builtin_amdgcn_mfma_f32_32x32x16_bf16(pa1, PK(l1, h1), od, 0, 0, 0);
    od = __builtin_amdgcn_mfma_f32_32x32x16_bf16(pa2, PK(l2, h2), od, 0, 0, 0);
    od = __builtin_amdgcn_mfma_f32_32x32x16_bf16(pa3, PK(l3, h3), od, 0, 0, 0);
#undef PK
}
__device__ __forceinline__ void pv_d0(f32x16 (&o)[4], int vb, bf16x8 pa0, bf16x8 pa1, bf16x8 pa2, bf16x8 pa3) {
    pv_one<0>(o[0], vb, pa0, pa1, pa2, pa3); pv_one<1>(o[1], vb, pa0, pa1, pa2, pa3); pv_one<2>(o[2], vb, pa0, pa1, pa2, pa3); pv_one<3>(o[3], vb, pa0, pa1, pa2, pa3);
}
template <int pass> __device__ __forceinline__ void attn_pass(const bf16* Z, float* O1, int qrow0, int crow0, int lrow0, int ntc, int nt, int h, LAS char* lds, int wv) {
    const int tid = tid_opaque(wv), wid = tid >> 6, lane = tid & 63, r32 = lane & 31, hi = lane >> 5;
    LAS char* V_lds = lds; LAS char* K_lds = lds + 2 * AT_SHM_V;
    LAS float* ws = (LAS float*)(lds + 2 * AT_SHM_V + 2 * AT_SHM_K) + wid * 64; LAS float* li_l = ws; LAS float* al_l = ws + 32;
    const int sr = tid >> 4, sc = (tid & 15) * 8, vst0 = v_st(sr, sc), vst1 = v_st(32 + sr, sc);
    const int srk = tid >> 3, sck = (tid & 7) * 8;
    const int vgo0 = sr * ZC + sc, kgo0 = srk * ZC + sck, kst0 = KSWZ64(srk, sck * 2);
    const int vb0 = (int)(uintptr_t)V_lds + v_rd_base(lane);
    {
        float m_reg = -1e30f, l_reg = 0; f32x16 o[4] = {}; bf16x8 qr[4];
        const bf16* Qw = Z + (size_t)(qrow0 + wid * 32 + r32) * ZC + 1280 + h * 128 + pass * 64 + hi * 8;
#pragma unroll
        for (int d0 = 0; d0 < 4; ++d0) qr[d0] = *(const bf16x8*)(Qw + d0 * 16);
        const bf16* Kc = Z + 1792 + h * 128 + pass * 64; const bf16* Vc = Z + 2304 + h * 128;
        struct { bf16x8 vs0, vs1, ks0; } sr_[2];
#define KROW(t) ((t) < ntc ? crow0 + (t) * 64 : lrow0 + ((t) - ntc) * 64)
#define SLOAD(i, t) do { const size_t _r = (size_t)__builtin_amdgcn_readfirstlane(KROW(t)) * ZC; const bf16* _v = Vc + _r; const bf16* _k = Kc + _r; \
    sr_[i].vs0 = *(const bf16x8*)(_v + vgo0); sr_[i].vs1 = *(const bf16x8*)(_v + vgo0 + 32 * ZC); sr_[i].ks0 = *(const bf16x8*)(_k + kgo0); } while (0)
#define SWRITE(b, i) do { *(LAS bf16x8*)(V_lds + (b) * AT_SHM_V + vst0) = sr_[i].vs0; *(LAS bf16x8*)(V_lds + (b) * AT_SHM_V + vst1) = sr_[i].vs1; \
    *(LAS bf16x8*)(K_lds + (b) * AT_SHM_K + kst0) = sr_[i].ks0; } while (0)
#define SWAIT() asm volatile("s_waitcnt vmcnt(3)" ::: "memory")
#define RESC(a) do { if (__any((a) < 1.f)) { if (hi == 0) al_l[r32] = (a); asm volatile("s_waitcnt lgkmcnt(0)" ::: "memory"); \
    _Pragma("unroll") for (int d = 0; d < 4; ++d) _Pragma("unroll") for (int r = 0; r < 16; ++r) o[d][r] *= al_l[crow(r, hi)]; } } while (0)
        f32x16 pA0, pA1, pB0, pB1; float mnA, mnB, alA, alB; bf16x8 pa0, pa1, pa2, pa3;
        __syncthreads();
        SLOAD(0, 0); asm volatile("s_waitcnt vmcnt(0)" ::: "memory"); SWRITE(0, 0); __syncthreads();
        qkt(pA0, pA1, K_lds, qr, r32, hi); partialSM(pA0, pA1, m_reg, mnA, alA);
        SLOAD(1, 1); if (2 < nt) SLOAD(0, 2);
        SWAIT(); SWRITE(1, 1); __syncthreads();
        for (int j = 1; j + 1 < nt; j += 2) {
            SBAR(); qkt(pB0, pB1, K_lds + AT_SHM_K, qr, r32, hi);
            finishSM(pA0, pA1, alA, l_reg, pa0, pa1, pa2, pa3); SBAR();
            SLOAD(1, j + 2); SBAR();
            pv_d0(o, vb0, pa0, pa1, pa2, pa3); partialSM(pB0, pB1, m_reg, mnB, alB);
            __syncthreads(); SWAIT(); SWRITE(0, 0);
            RESC(alB); __syncthreads();
            SBAR(); qkt(pA0, pA1, K_lds, qr, r32, hi);
            finishSM(pB0, pB1, alB, l_reg, pa0, pa1, pa2, pa3); SBAR();
            if (j + 3 < nt) SLOAD(0, j + 3); SBAR();
            pv_d0(o, vb0 + AT_SHM_V, pa0, pa1, pa2, pa3); partialSM(pA0, pA1, m_reg, mnA, alA);
            __syncthreads(); SWAIT(); SWRITE(1, 1);
            RESC(alA); __syncthreads();
        }
        SBAR(); qkt(pB0, pB1, K_lds + AT_SHM_K, qr, r32, hi);
        finishSM(pA0, pA1, alA, l_reg, pa0, pa1, pa2, pa3); SBAR();
        pv_d0(o, vb0, pa0, pa1, pa2, pa3); partialSM(pB0, pB1, m_reg, mnB, alB);
        __syncthreads(); RESC(alB);
        finishSM(pB0, pB1, alB, l_reg, pa0, pa1, pa2, pa3); SBAR();
        pv_d0(o, vb0 + AT_SHM_V, pa0, pa1, pa2, pa3);
        if (hi == 0) li_l[r32] = l_reg; asm volatile("s_waitcnt lgkmcnt(0)" ::: "memory");
#pragma unroll
        for (int r = 0; r < 16; ++r) { const float rl_ = __builtin_amdgcn_rcpf(li_l[crow(r, hi)]);
#pragma unroll
            for (int d0 = 0; d0 < 4; ++d0) o[d0][r] *= rl_; }
        const int orow0 = qrow0 + wid * 32;
        float* Op = O1 + (size_t)pass * ((size_t)R * 512);
#pragma unroll
        for (int r = 0; r < 16; ++r)
#pragma unroll
            for (int d0 = 0; d0 < 4; ++d0) Op[(size_t)(orow0 + crow(r, hi)) * 512 + h * 128 + d0 * 32 + r32] = o[d0][r];
    }
#undef KROW
#undef SLOAD
#undef SWRITE
#undef SWAIT
#undef RESC
}
__device__ __forceinline__ void attn_combine(float* O1, bf16* Y, int qrow0, int h, float lam, float osc, const float* subg, int wv) {
    const int tid = tid_opaque(wv), wid = tid >> 6, lane = tid & 63;
    asm volatile("s_waitcnt vmcnt(0)" ::: "memory");
    {
        const float* O2 = O1 + (size_t)R * 512; const int orow0 = qrow0 + wid * 32;
        const float g0 = subg[lane] * osc, g1 = subg[64 + lane] * osc;
        for (int rr = 0; rr < 32; ++rr) {
            const size_t o_ = (size_t)(orow0 + rr) * 512 + h * 128 + lane;
            const float a0 = __hip_atomic_load(O1 + o_, __ATOMIC_RELAXED, __HIP_MEMORY_SCOPE_AGENT), a1 = __hip_atomic_load(O1 + o_ + 64, __ATOMIC_RELAXED, __HIP_MEMORY_SCOPE_AGENT);
            const float b0 = __hip_atomic_load(O2 + o_, __ATOMIC_RELAXED, __HIP_MEMORY_SCOPE_AGENT), b1 = __hip_atomic_load(O2 + o_ + 64, __ATOMIC_RELAXED, __HIP_MEMORY_SCOPE_AGENT);
            const float v0 = a0 - lam * b0, v1 = a1 - lam * b1;
            const float ss = wave_sum(v0 * v0 + v1 * v1);
            const float rs = 1.0f / sqrtf(ss * (1.f / 128.f) + RMS_EPS);
            bf16* yr = Y + (size_t)(orow0 + rr) * YC + 512 + h * 128 + lane;
            yr[0] = f2bf(v0 * rs * g0); yr[64] = f2bf(v1 * rs * g1);
        }
    }
}

__device__ __forceinline__ float dpp_row_sum(float v) {
    v += __int_as_float(__builtin_amdgcn_update_dpp(0, __float_as_int(v), 0xB1, 0xF, 0xF, true));
    v += __int_as_float(__builtin_amdgcn_update_dpp(0, __float_as_int(v), 0x4E, 0xF, 0xF, true));
    v += __int_as_float(__builtin_amdgcn_update_dpp(0, __float_as_int(v), 0x141, 0xF, 0xF, true));
    v += __int_as_float(__builtin_amdgcn_update_dpp(0, __float_as_int(v), 0x140, 0xF, 0xF, true));
    return v;
}
__device__ __forceinline__ float dpp_row_max(float v) {
    v = fmaxf(v, __int_as_float(__builtin_amdgcn_update_dpp(0, __float_as_int(v), 0xB1, 0xF, 0xF, true)));
    v = fmaxf(v, __int_as_float(__builtin_amdgcn_update_dpp(0, __float_as_int(v), 0x4E, 0xF, 0xF, true)));
    v = fmaxf(v, __int_as_float(__builtin_amdgcn_update_dpp(0, __float_as_int(v), 0x141, 0xF, 0xF, true)));
    v = fmaxf(v, __int_as_float(__builtin_amdgcn_update_dpp(0, __float_as_int(v), 0x140, 0xF, 0xF, true)));
    return v;
}
__device__ __forceinline__ float wave_sum_fast(float v) {
    v = dpp_row_sum(v);
    const float r0 = __int_as_float(__builtin_amdgcn_readlane(__float_as_int(v), 0)), r1 = __int_as_float(__builtin_amdgcn_readlane(__float_as_int(v), 16));
    const float r2 = __int_as_float(__builtin_amdgcn_readlane(__float_as_int(v), 32)), r3 = __int_as_float(__builtin_amdgcn_readlane(__float_as_int(v), 48));
    return (r0 + r1) + (r2 + r3);
}
__device__ __forceinline__ void row_stats(const f32x4 (&v)[4], float& mean, float& rstd) {
    float s = 0.f;
#pragma unroll
    for (int j = 0; j < 4; ++j) s += (v[j][0] + v[j][1]) + (v[j][2] + v[j][3]);
    mean = wave_sum_fast(s) * (1.f / D); float q = 0.f;
#pragma unroll
    for (int j = 0; j < 4; ++j) { const f32x4 d = v[j] - mean; q += (d[0] * d[0] + d[1] * d[1]) + (d[2] * d[2] + d[3] * d[3]); }
    rstd = 1.0f / sqrtf(wave_sum_fast(q) * (1.f / D) + LN_EPS);
}
template <bool WANT>
__device__ __forceinline__ void store_h(bf16* HLrow, const f32x4 (&v)[4], float mean, float rstd, const float* shift, const float* scale, int lane, f32x4 (&hv)[4]) {
#pragma unroll
    for (int j = 0; j < 4; ++j) { const int c = 4 * lane + 256 * j; const f32x4 sh = *(const f32x4*)(shift + c), sc = *(const f32x4*)(scale + c);
        const f32x4 h = (v[j] - mean) * rstd * (sc + 1.f) + sh; u32x2 w; w.x = cvt_pk_bf16(h[0], h[1]); w.y = cvt_pk_bf16(h[2], h[3]); *(u32x2*)(HLrow + c) = w; if (WANT) hv[j] = h; }
}
template <int MODE, bool DUMMY = false>
__device__ __forceinline__ void ph_ln(const Args& a, int l, bool last, LAS unsigned char* lds, int G, int wg, int wv) {
    const int tid = tid_opaque(wv), lane = tid & 63, wave = tid >> 6, gw = wg * 8 + wave, NGW = G * 8;
    const float* X = (const float*)(a.ws + WS_X); float* Xo = DUMMY ? (float*)(a.ws + 970 * MiB) : (float*)(a.ws + WS_X); bf16* HL = DUMMY ? (bf16*)(a.ws + 1043 * MiB) : (bf16*)(a.ws + WS_HL); const float* ADA = (const float*)(a.ws + WS_ADA);
    LAS float* wr_l = (LAS float*)lds;
    if (MODE == 1) {
        const float* wrt = a.in[I_WROUTER] + (size_t)l * D * NE;
        for (int i = tid; i < D * NE; i += 512) { const int k = i >> 4, e = i & 15; wr_l[e * D + k] = wrt[i]; }
        __syncthreads();
    }
    const int nrows = (MODE != 0 && last) ? RL : R;
    for (int row0 = gw * 2; row0 < nrows; row0 += NGW * 2) {
        const int bc = row0 < RL ? (row0 >> 11) : 8;
        f32x4 v[2][4]; float mean[2], rstd[2];
        if (MODE == 0) {
#pragma unroll
            for (int rr = 0; rr < 2; ++rr) { const int row = row0 + rr; const float* src = row < RL ? a.in[I_X] + (size_t)row * D : a.in[I_CTX] + (size_t)(row - RL) * D;
#pragma unroll
                for (int j = 0; j < 4; ++j) { v[rr][j] = *(const f32x4*)(src + 4 * lane + 256 * j); *(f32x4*)(Xo + (size_t)row * D + 4 * lane + 256 * j) = v[rr][j]; } }
            const float* ad = ADA + (size_t)(0 * 9 + bc) * 6144; f32x4 hv[4];
#pragma unroll
            for (int rr = 0; rr < 2; ++rr) { row_stats(v[rr], mean[rr], rstd[rr]); store_h<false>(HL + (size_t)(row0 + rr) * D, v[rr], mean[rr], rstd[rr], ad, ad + 1024, lane, hv); }
        } else {
            const float* ad = ADA + (size_t)(l * 9 + bc) * 6144;
            const float* gate = ad + (MODE == 1 ? 2048 : 5120);
            if (MODE == 1) {
                f32x4 tv[2][4];
#pragma unroll
                for (int rr = 0; rr < 2; ++rr) { const float* T = (const float*)(a.ws + WS_R2) + (size_t)(row0 + rr) * D;
#pragma unroll
                    for (int j = 0; j < 4; ++j) { const int c = 4 * lane + 256 * j; v[rr][j] = *(const f32x4*)(X + (size_t)(row0 + rr) * D + c); tv[rr][j] = *(const f32x4*)(T + c); } }
#pragma unroll
                for (int j = 0; j < 4; ++j) { const f32x4 gt = *(const f32x4*)(gate + 4 * lane + 256 * j);
#pragma unroll
                    for (int rr = 0; rr < 2; ++rr) v[rr][j] = v[rr][j] * DN_ALPHA + gt * tv[rr][j]; }
            } else {
                const bf16* YE = (const bf16*)(a.ws + WS_R2 + 72 * MiB);
                f32x4 mo[2][4];
#pragma unroll
                for (int rr = 0; rr < 2; ++rr) {
#pragma unroll
                    for (int j = 0; j < 4; ++j) { v[rr][j] = *(const f32x4*)(X + (size_t)(row0 + rr) * D + 4 * lane + 256 * j); mo[rr][j] = (f32x4){0.f, 0.f, 0.f, 0.f}; } }
                const int* INV = (const int*)(a.ws + WS_INV) + (size_t)row0 * 16;
                const int myinv = lane < 32 ? INV[lane] : -1;
                unsigned long long mask = __ballot(myinv >= 0);
                while (mask) { const int src = __builtin_ctzll(mask); mask &= mask - 1; const int r = __builtin_amdgcn_readlane(myinv, src);
                    u32x2 w[4];
#pragma unroll
                    for (int j = 0; j < 4; ++j) w[j] = *(const u32x2*)(YE + (size_t)r * 1024 + 4 * lane + 256 * j);
                    if (src < 16) {
#pragma unroll
                        for (int j = 0; j < 4; ++j) { mo[0][j][0] += bflo(w[j].x); mo[0][j][1] += bfhi(w[j].x); mo[0][j][2] += bflo(w[j].y); mo[0][j][3] += bfhi(w[j].y); }
                    } else {
#pragma unroll
                        for (int j = 0; j < 4; ++j) { mo[1][j][0] += bflo(w[j].x); mo[1][j][1] += bfhi(w[j].x); mo[1][j][2] += bflo(w[j].y); mo[1][j][3] += bfhi(w[j].y); }
                    } }
#pragma unroll
                for (int j = 0; j < 4; ++j) { const f32x4 gt = *(const f32x4*)(gate + 4 * lane + 256 * j);
#pragma unroll
                    for (int rr = 0; rr < 2; ++rr) v[rr][j] = v[rr][j] * DN_ALPHA + gt * mo[rr][j]; }
            }
#pragma unroll
            for (int rr = 0; rr < 2; ++rr) row_stats(v[rr], mean[rr], rstd[rr]);
            const float* g = a.in[MODE == 1 ? I_LN1G : I_LN2G] + l * D; const float* b = a.in[MODE == 1 ? I_LN1B : I_LN2B] + l * D;
#pragma unroll
            for (int j = 0; j < 4; ++j) { const int c = 4 * lane + 256 * j; const f32x4 gg = *(const f32x4*)(g + c), bb = *(const f32x4*)(b + c);
#pragma unroll
                for (int rr = 0; rr < 2; ++rr) { v[rr][j] = (v[rr][j] - mean[rr]) * rstd[rr] * gg + bb; *(f32x4*)(Xo + (size_t)(row0 + rr) * D + c) = v[rr][j];
                    if (MODE == 2 && last) *(f32x4*)((DUMMY ? Xo + (size_t)R * D / 2 : a.out) + (size_t)(row0 + rr) * D + c) = v[rr][j]; } }
            if (MODE == 1 || !last) {
                const float* ad2 = MODE == 1 ? ad + 3072 : ADA + (size_t)((l + 1) * 9 + bc) * 6144;
#pragma unroll
                for (int rr = 0; rr < 2; ++rr) row_stats(v[rr], mean[rr], rstd[rr]);
#pragma unroll
                for (int rr = 0; rr < 2; ++rr) {
                    f32x4 hv[4];
                    store_h<MODE == 1>(HL + (size_t)(row0 + rr) * D, v[rr], mean[rr], rstd[rr], ad2, ad2 + 1024, lane, hv);
                    if (MODE == 1) {
                        float lg[16];
#pragma unroll
                        for (int e = 0; e < 16; ++e) { float s_ = 0.f;
#pragma unroll
                            for (int j = 0; j < 4; ++j) { const f32x4 w = *(const LAS f32x4*)(wr_l + e * D + 4 * lane + 256 * j); s_ += (hv[j][0] * w[0] + hv[j][1] * w[1]) + (hv[j][2] * w[2] + hv[j][3] * w[3]); }
                            lg[e] = dpp_row_sum(s_); }
                        float m_ = 0.f;
#pragma unroll
                        for (int e = 0; e < 16; ++e) m_ = ((lane & 15) == e) ? lg[e] : m_;
                        m_ += __shfl_xor(m_, 16); m_ += __shfl_xor(m_, 32);
                        const float mx = dpp_row_max(m_), ex = expf(m_ - mx), se = dpp_row_sum(ex);
                        float* AFF = DUMMY ? (float*)(a.ws + 1080 * MiB) : (float*)(a.ws + WS_AFF); const int row = row0 + rr;
                        if (lane < 16) {
                            if (row < RL) AFF[((size_t)(row >> 11) * 16 + lane) * 2048 + (row & 2047)] = ex / se;
                            else { const int rc = row - RL; AFF[(size_t)8 * 16 * 2048 + ((size_t)(rc >> 8) * 16 + lane) * 256 + (rc & 255)] = ex / se; }
                        }
                    }
                }
            }
        }
    }
}

__device__ __forceinline__ int block_excl_scan(int v, LAS int* wtot, int lane, int wave, int& total) {
    int inc = v;
#pragma unroll
    for (int o = 1; o < 64; o <<= 1) { const int t = __shfl_up(inc, o); if (lane >= o) inc += t; }
    if (lane == 63) wtot[wave] = inc;
    __syncthreads();
    int base = 0, tot = 0;
#pragma unroll
    for (int w = 0; w < 8; ++w) { const int x = wtot[w]; tot += x; if (w < wave) base += x; }
    __syncthreads();
    total = tot; return base + inc - v;
}
__device__ __forceinline__ void ph_topk(const Args& a, bool last, LAS unsigned char* lds, int G, int wg, int wv) {
    const int tid = tid_opaque(wv), lane = tid & 63, wave = tid >> 6;
    LAS unsigned* cnt = (LAS unsigned*)lds; LAS int* wtot = (LAS int*)(lds + 256);
    const float* AFF = (const float*)(a.ws + WS_AFF); int* IDX = (int*)(a.ws + WS_IDX); float* GV = (float*)(a.ws + WS_GV); int* INV = (int*)(a.ws + WS_INV);
    const int nunits = last ? 128 : 256;
    for (int u = wg; u < nunits; u += G) {
        const bool lat = u < 128; const int b = lat ? (u >> 4) : ((u - 128) >> 4), e = u & 15;
        const int n = lat ? 2048 : 256, cap = lat ? CAPL : CAPC;
        const float* af = lat ? AFF + ((size_t)b * 16 + e) * 2048 : AFF + (size_t)8 * 16 * 2048 + ((size_t)b * 16 + e) * 256;
        const int rowbase = lat ? b * 2048 : RL + b * 256;
        const int hid0 = lat ? (e * 8 + b) * 256 : 32768 + e * 256 + b * 32;
        unsigned key[4]; const int t0 = 4 * tid;
        if (t0 < n) { const u32x4 kv = *(const u32x4*)(af + t0); key[0] = kv.x; key[1] = kv.y; key[2] = kv.z; key[3] = kv.w; } else { key[0] = key[1] = key[2] = key[3] = 0u; }
        if (tid < 32) cnt[tid] = 0u;
        __syncthreads();
        unsigned prefix = 0u; int rem = cap;
        for (int bit = 30; bit >= 0; --bit) {
            const unsigned want = (prefix >> bit) | 1u;
            int c = 0;
#pragma unroll
            for (int j = 0; j < 4; ++j) c += ((key[j] >> bit) == want) ? 1 : 0;
            c = wave_sum_i(c);
            if (lane == 0 && c) __hip_atomic_fetch_add(&cnt[bit], (unsigned)c, __ATOMIC_RELAXED, __HIP_MEMORY_SCOPE_WORKGROUP);
            __syncthreads();
            const int tot = (int)cnt[bit];
            if (tot >= rem) prefix |= (1u << bit); else rem -= tot;
        }
        int eqc = 0;
#pragma unroll
        for (int j = 0; j < 4; ++j) eqc += (key[j] == prefix) ? 1 : 0;
        int dummy; int eqb = block_excl_scan(eqc, wtot, lane, wave, dummy);
        bool sel[4]; int selc = 0;
#pragma unroll
        for (int j = 0; j < 4; ++j) { bool s = key[j] > prefix; if (key[j] == prefix) { s = eqb < rem; ++eqb; } sel[j] = s; selc += s ? 1 : 0; }
        int slot = block_excl_scan(selc, wtot, lane, wave, dummy);
        if (t0 < n) {
#pragma unroll
            for (int j = 0; j < 4; ++j) { const int row = rowbase + t0 + j;
                if (sel[j]) { IDX[hid0 + slot] = row; GV[hid0 + slot] = __uint_as_float(key[j]); INV[(size_t)row * 16 + e] = hid0 + slot; ++slot; }
                else INV[(size_t)row * 16 + e] = -1; }
        }
        __syncthreads();
    }
}

constexpr int VT_LD = 136;
__device__ __forceinline__ void ph_prep(const Args& a, int l, bool last, LAS unsigned char* lds, int G, int wg, int wv) {
    const int tid = tid_opaque(wv), lane = tid & 63, wave = __builtin_amdgcn_readfirstlane(tid >> 6), fr = lane & 15, fq = lane >> 4;
    const bf16* Z = (const bf16*)(a.ws + WS_R1); bf16* Y = (bf16*)(a.ws + WS_Y);
    const bf16* Wb = (const bf16*)(a.ws + WS_WSPB) + (size_t)l * 4 * 128 * 128;
    LAS bf16* vT = (LAS bf16*)lds;
    const int nch = last ? 128 : 144;
    for (int ck = wg; ck < nch; ck += G) {
        const int r0 = ck * 128;
        {
            float g[4], bb[4];
#pragma unroll
            for (int i = 0; i < 4; ++i) { g[i] = a.in[I_SGUG][l * 256 + lane + 64 * i]; bb[i] = a.in[I_SGUB][l * 256 + lane + 64 * i]; }
#pragma unroll 2
            for (int i2 = 0; i2 < 8; ++i2) { const int q = wave * 16 + i2 * 2;
                float x[2][4];
#pragma unroll
                for (int rr = 0; rr < 2; ++rr)
#pragma unroll
                    for (int i = 0; i < 4; ++i) x[rr][i] = bf2f(Z[(size_t)(r0 + q + rr) * ZC + 256 + lane + 64 * i]);
#pragma unroll
                for (int rr = 0; rr < 2; ++rr) {
                    const float mean = wave_sum_fast((x[rr][0] + x[rr][1]) + (x[rr][2] + x[rr][3])) * (1.f / 256.f);
#pragma unroll
                    for (int i = 0; i < 4; ++i) x[rr][i] -= mean;
                    const float var = wave_sum_fast((x[rr][0] * x[rr][0] + x[rr][1] * x[rr][1]) + (x[rr][2] * x[rr][2] + x[rr][3] * x[rr][3])) * (1.f / 256.f);
                    const float rstd = 1.0f / sqrtf(var + LN_EPS);
#pragma unroll
                    for (int i = 0; i < 4; ++i) x[rr][i] = x[rr][i] * rstd * g[i] + bb[i];
                }
#pragma unroll
                for (int i = 0; i < 4; ++i) *(LAS unsigned*)(vT + (lane + 64 * i) * VT_LD + q) = cvt_pk_bf16(x[0][i], x[1][i]);
            }
        }
        __syncthreads();
        {
            const int g = wave & 3, ph = wave >> 2;
            f32x4 acc[4][4];
#pragma unroll
            for (int ct = 0; ct < 4; ++ct)
#pragma unroll
                for (int pt = 0; pt < 4; ++pt) acc[ct][pt] = (f32x4){0.f, 0.f, 0.f, 0.f};
            const bf16* Wg = Wb + (size_t)(g * 128 + ph * 64 + fr) * 128 + fq * 8;
            const LAS bf16* vA = vT + (g * 64 + fr) * VT_LD + fq * 8;
#pragma unroll
            for (int kk = 0; kk < 4; ++kk) {
                bf16x8 af[4], bfm[4];
#pragma unroll
                for (int ct = 0; ct < 4; ++ct) af[ct] = *(const LAS bf16x8*)(vA + ct * 16 * VT_LD + kk * 32);
#pragma unroll
                for (int pt = 0; pt < 4; ++pt) bfm[pt] = *(const bf16x8*)(Wg + pt * 16 * 128 + kk * 32);
#pragma unroll
                for (int ct = 0; ct < 4; ++ct)
#pragma unroll
                    for (int pt = 0; pt < 4; ++pt) acc[ct][pt] = __builtin_amdgcn_mfma_f32_16x16x32_bf16(af[ct], bfm[pt], acc[ct][pt], 0, 0, 0);
            }
            const float* bsp = a.in[I_BSP] + (l * 4 + g) * 128;
#pragma unroll
            for (int pt = 0; pt < 4; ++pt) { const int p = ph * 64 + pt * 16 + fr; const float bias = bsp[p]; const size_t row = (size_t)(r0 + p);
#pragma unroll
                for (int ct = 0; ct < 4; ++ct) { const int c = g * 64 + ct * 16 + 4 * fq; const u32x2 uw = *(const u32x2*)(Z + row * ZC + c);
                    u32x2 o; o.x = cvt_pk_bf16(bflo(uw.x) * (acc[ct][pt][0] + bias), bfhi(uw.x) * (acc[ct][pt][1] + bias)); o.y = cvt_pk_bf16(bflo(uw.y) * (acc[ct][pt][2] + bias), bfhi(uw.y) * (acc[ct][pt][3] + bias));
                    *(u32x2*)(Y + row * YC + c) = o; } }
        }
        {
            const int c0 = (tid & 31) * 8, rr0 = tid >> 5; const int seqlen = r0 < RL ? 2048 : 256;
            float w0[8], w1[8], w2[8];
#pragma unroll
            for (int j = 0; j < 8; ++j) { w0[j] = a.in[I_CONVW][(l * 3 + 0) * 256 + c0 + j]; w1[j] = a.in[I_CONVW][(l * 3 + 1) * 256 + c0 + j]; w2[j] = a.in[I_CONVW][(l * 3 + 2) * 256 + c0 + j]; }
            for (int ps = 0; ps < 8; ++ps) { const int row = r0 + ps * 16 + rr0; const bf16* zr = Z + (size_t)row * ZC;
                const bool hp = (row % seqlen) != 0, hn = ((row + 1) % seqlen) != 0;
                float yc[8], yp[8], yn[8], gbv[8], t0[8], t1[8];
                unpack8(*(const u32x4*)(zr + 768 + c0), t0); unpack8(*(const u32x4*)(zr + 1024 + c0), t1);
#pragma unroll
                for (int j = 0; j < 8; ++j) yc[j] = t0[j] * t1[j];
                if (hp) { unpack8(*(const u32x4*)(zr - ZC + 768 + c0), t0); unpack8(*(const u32x4*)(zr - ZC + 1024 + c0), t1); }
#pragma unroll
                for (int j = 0; j < 8; ++j) yp[j] = hp ? t0[j] * t1[j] : 0.f;
                if (hn) { unpack8(*(const u32x4*)(zr + ZC + 768 + c0), t0); unpack8(*(const u32x4*)(zr + ZC + 1024 + c0), t1); }
#pragma unroll
                for (int j = 0; j < 8; ++j) yn[j] = hn ? t0[j] * t1[j] : 0.f;
                unpack8(*(const u32x4*)(zr + 512 + c0), gbv);
                f32x4 o0, o1;
#pragma unroll
                for (int j = 0; j < 4; ++j) { o0[j] = gbv[j] * (w0[j] * yp[j] + w1[j] * yc[j] + w2[j] * yn[j]); o1[j] = gbv[4 + j] * (w0[4 + j] * yp[4 + j] + w1[4 + j] * yc[4 + j] + w2[4 + j] * yn[4 + j]); }
                *(u32x4*)(Y + (size_t)row * YC + 256 + c0) = pack8(o0, o1);
            }
        }
        __syncthreads();
    }
}

__device__ __forceinline__ void ph_ada(const Args& a, LAS unsigned char* lds, int G, int wg, int wv) {
    const int tid = tid_opaque(wv);
    LAS float* sc = (LAS float*)lds; LAS float* red = sc + 9 * 1024;
    for (int i = tid; i < 9 * 1024; i += 512) { const int bc = i >> 10, k = i & 1023; const float v = bc < 8 ? a.in[I_C][bc * 1024 + k] : a.in[I_CCTX][k]; sc[i] = v / (1.f + expf(-v)); }
    __syncthreads();
    float* ADA = (float*)(a.ws + WS_ADA);
    for (int u = wg; u < 96; u += G) {
        const int l = u / 24, cb = u % 24, cl = tid & 255, col = cb * 256 + cl, kh = tid >> 8;
        const float* w = a.in[I_WADA] + (size_t)l * 1024 * 6144 + col;
        float acc[9];
#pragma unroll
        for (int bc = 0; bc < 9; ++bc) acc[bc] = 0.f;
#pragma unroll 8
        for (int k = kh * 512; k < kh * 512 + 512; ++k) { const float wv = w[(size_t)k * 6144];
#pragma unroll
            for (int bc = 0; bc < 9; ++bc) acc[bc] += sc[bc * 1024 + k] * wv; }
        if (kh == 1) {
#pragma unroll
            for (int bc = 0; bc < 9; ++bc) red[cl * 9 + bc] = acc[bc]; }
        __syncthreads();
        if (kh == 0) { const float bv = a.in[I_BADA][l * 6144 + col];
#pragma unroll
            for (int bc = 0; bc < 9; ++bc) ADA[(size_t)(l * 9 + bc) * 6144 + col] = acc[bc] + red[cl * 9 + bc] + bv; }
        __syncthreads();
    }
}
template <class RowMap>
__device__ __forceinline__ void transpose_item(const float* W, int ldw, int k0, int n0, const RowMap& rm, LAS float* scr, int lane) {
    const int kr = lane >> 3, nq = lane & 7;
    f32x4 v[8];
#pragma unroll
    for (int i = 0; i < 8; ++i) v[i] = *(const f32x4*)(W + (size_t)(k0 + 8 * i + kr) * ldw + n0 + 4 * nq);
#pragma unroll
    for (int i = 0; i < 8; ++i) { LAS float* d = scr + (8 * i + kr) * 33 + 4 * nq; d[0] = v[i][0]; d[1] = v[i][1]; d[2] = v[i][2]; d[3] = v[i][3]; }
    LDS_WAIT(); asm volatile("" ::: "memory");
    const int c = lane & 7;
#pragma unroll
    for (int j = 0; j < 4; ++j) { const int n = (lane >> 3) + 8 * j; const LAS float* s = scr + (8 * c) * 33 + n;
        u32x4 o; o.x = cvt_pk_bf16(s[0 * 33], s[1 * 33]); o.y = cvt_pk_bf16(s[2 * 33], s[3 * 33]); o.z = cvt_pk_bf16(s[4 * 33], s[5 * 33]); o.w = cvt_pk_bf16(s[6 * 33], s[7 * 33]);
        *(u32x4*)(rm(n0 + n) + k0 + 8 * c) = o; }
    LDS_WAIT(); asm volatile("" ::: "memory");
}
constexpr int CV_ITEMS = 1408 + 2048 + 128 + 128 + 256 + 512 + 512 + 3 * 8192;
__device__ __forceinline__ void convert_items(const Args& a, LAS unsigned char* lds, int l, int lo, int hi, int wrank, int nw, int wv) {
    const int tid = tid_opaque(wv), lane = tid & 63, wave = __builtin_amdgcn_readfirstlane(tid >> 6);
    LAS float* scr = (LAS float*)(lds + wave * 16384);
    constexpr int C0 = 1408, C1 = C0 + 2048, C2 = C1 + 128, C3 = C2 + 128, C4 = C3 + 256, C5 = C4 + 512, C6 = C5 + 512, C7 = C6, C8 = C7 + 8192, C9 = C8 + 8192, C10 = C9 + 8192;
    static_assert(C10 == CV_ITEMS, "item count");
    for (int r = lo + wrank; r < hi; r += nw) {
        unsigned char* wl = a.ws + WS_W + (size_t)l * WL_STRIDE;
        if (r < C0) { const int kb = r / 88, nb = r % 88; bf16* dst = (bf16*)(wl + WL_IN);
            transpose_item(a.in[I_WIN] + (size_t)l * D * 3072, 3072, kb * 64, nb * 32, [=](int n) { return dst + (size_t)n * D; }, scr, lane); }
        else if (r < C1) { const int q = r - C0, kb = q / 128, nb = q % 128; bf16* dst = (bf16*)(wl + WL_G);
            transpose_item(a.in[I_WGATE] + (size_t)l * D * 4096, 4096, kb * 64, nb * 32,
                           [=](int n) { const int br = n >> 10, cc = n & 1023; return dst + (size_t)((cc >> 6) * 256 + (br >> 1) * 128 + ((cc >> 4) & 3) * 32 + (br & 1) * 16 + (cc & 15)) * D; }, scr, lane); }
        else if (r < C5) { int q, br, K, rep = 0; if (r < C2) { q = r - C1; br = 0; K = 256; } else if (r < C3) { q = r - C2; br = 1; K = 256; } else if (r < C4) { q = r - C3; br = 2; K = 512; } else { q = (r - C4) & 127; rep = (r - C4) >> 7; br = 3; K = 256; }
            const float* src = a.in[I_WPA + br] + (size_t)l * K * D; const int kb = q / 32, nb = q % 32; bf16* dst = (bf16*)(wl + WL_P) + (size_t)br * 1024 * 1024 + rep * 256;
            transpose_item(src, D, kb * 64, nb * 32, [=](int n) { return dst + (size_t)n * 1024; }, scr, lane); }
        else if (r < C7) { const int q = r - C5, kb = q / 32, nb = q % 32; bf16* dst = (bf16*)(wl + WL_O);
            transpose_item(a.in[I_WO] + (size_t)l * D * D, D, kb * 64, nb * 32, [=](int n) { return dst + (size_t)n * MC; }, scr, lane); }
        else if (r < C9) { const int up = r >= C8 ? 1 : 0, q = r - (up ? C8 : C7), e = q >> 9, qq = q & 511, kb = qq / 32, nb = qq % 32; bf16* dst = (bf16*)(wl + WL_GU) + (size_t)e * 2048 * D;
            transpose_item(a.in[up ? I_WEU : I_WEG] + ((size_t)l * NE + e) * D * D, D, kb * 64, nb * 32, [=](int n) { return dst + (size_t)((n >> 7) * 256 + up * 128 + (n & 127)) * D; }, scr, lane); }
        else { const int q = r - C9, e = q >> 9, qq = q & 511, kb = qq / 32, nb = qq % 32; bf16* dst = (bf16*)(wl + WL_D) + (size_t)e * D * D;
            transpose_item(a.in[I_WED] + ((size_t)l * NE + e) * D * D, D, kb * 64, nb * 32, [=](int n) { return dst + (size_t)n * D; }, scr, lane); }
    }
}
__device__ __forceinline__ void conv_hole(const Args& a, LAS unsigned char* lds, int lnext, int lo, int hi, int U, int G, int wg, int wv) {
    const int rem = U % G; if (rem == 0 || wg < rem) return;
    const int wave = __builtin_amdgcn_readfirstlane(tid_opaque(wv) >> 6);
    convert_items(a, lds, lnext, lo, hi, (wg - rem) * 8 + wave, (G - rem) * 8, wv);
}
__device__ __forceinline__ void ph_weights(const Args& a, LAS unsigned char* lds, int G, int wg, int wv) {
    const int tid = tid_opaque(wv), lane = tid & 63, wave = __builtin_amdgcn_readfirstlane(tid >> 6);
    convert_items(a, lds, 0, 0, CV_ITEMS, wg * 8 + wave, G * 8, wv);
    __syncthreads();
    LAS float* ct = (LAS float*)lds;
    LAS float* wt = ct + 2048;
    for (int i = tid; i < 2048; i += 512) ct[i] = cospif((float)i * (1.f / 1024.f));
    __syncthreads();
    {
        bf16* FL = (bf16*)(a.ws + WS_FLAT); bf16* FC = (bf16*)(a.ws + WS_FCTX);
        const float sL = 0.022097086912079608f  , sC = 0.0625f  ;
        for (size_t i = (size_t)wg * 512 + tid; i < (size_t)2048 * 4096; i += (size_t)G * 512) { const int k1 = (int)(i >> 12), kk = (int)(i & 4095);
            const int n = kk & 2047, m = (k1 * n) & 2047; const float v = kk < 2048 ? ct[m] : -ct[(m + 1536) & 2047];
            FL[i] = f2bf(v * sL); }
        for (int i = wg * 512 + tid; i < 256 * 512; i += G * 512) { const int k1 = i >> 9, kk = i & 511; const int n = kk & 255, m = ((k1 * n) & 255) * 8;
            const float v = kk < 256 ? ct[m] : -ct[(m + 1536) & 2047]; FC[i] = f2bf(v * sC); }
    }
    {
        bf16* wb = (bf16*)(a.ws + WS_WSPB);
        for (int i = wg * 512 + tid; i < NL * 4 * 128 * 128; i += G * 512) wb[i] = f2bf(a.in[I_WSP][i]);
    }
    {
        float* rc = (float*)(a.ws + WS_ROPE); float* rs = rc + 2048 * 32;
        for (int i = wg * 512 + tid; i < 2048 * 32; i += G * 512) { const int t = i >> 5, p = i & 31; const int j = p & 15;
            const float inv = powf(10000.0f, -(float)(2 * j) / 32.0f); const float pos = p < 16 ? (float)(t >> 6) : (float)(t & 63); const float ang = pos * inv;
            rc[i] = cosf(ang); rs[i] = sinf(ang); }
        if (wg == 0 && tid < NL) { const int l = tid; float s1 = 0.f, s2 = 0.f;
            for (int k = 0; k < 64; ++k) { s1 += a.in[I_LQ1][l * 64 + k] * a.in[I_LK1][l * 64 + k]; s2 += a.in[I_LQ2][l * 64 + k] * a.in[I_LK2][l * 64 + k]; }
            ((float*)(a.ws + WS_LAM))[l] = expf(s1) - expf(s2) + (0.8f - 0.6f * expf(-0.3f * (float)l)); }
    }
    for (int u = wg; u < NL * 64; u += G) {
        const int l = u >> 6, k0 = (u & 63) * 16;
        __syncthreads();
        for (int i = tid; i < 16 * 256; i += 512) wt[i] = a.in[I_WIN][((size_t)l * D + k0 + (i >> 8)) * 3072 + 2816 + (i & 255)];
        __syncthreads();
        const int o = tid, ty = o >> 8, g = (o >> 6) & 3, k2 = o & 63;
        float acc[16];
#pragma unroll
        for (int kr = 0; kr < 16; ++kr) acc[kr] = 0.f;
        for (int c = 0; c < 64; ++c) { const int m = ((k2 * c) & 63) * 32; const float tw = ty == 0 ? ct[m] : ct[(m + 1536) & 2047];
#pragma unroll
            for (int kr = 0; kr < 16; ++kr) acc[kr] += wt[kr * 256 + g * 64 + c] * tw; }
        bf16* dst = (bf16*)(a.ws + WS_W + (size_t)l * WL_STRIDE + WL_IN) + (size_t)(2816 + o) * D + k0;
        u32x4 w0, w1;
        w0.x = cvt_pk_bf16(acc[0] * 0.125f, acc[1] * 0.125f); w0.y = cvt_pk_bf16(acc[2] * 0.125f, acc[3] * 0.125f); w0.z = cvt_pk_bf16(acc[4] * 0.125f, acc[5] * 0.125f); w0.w = cvt_pk_bf16(acc[6] * 0.125f, acc[7] * 0.125f);
        w1.x = cvt_pk_bf16(acc[8] * 0.125f, acc[9] * 0.125f); w1.y = cvt_pk_bf16(acc[10] * 0.125f, acc[11] * 0.125f); w1.z = cvt_pk_bf16(acc[12] * 0.125f, acc[13] * 0.125f); w1.w = cvt_pk_bf16(acc[14] * 0.125f, acc[15] * 0.125f);
        *(u32x4*)dst = w0; *(u32x4*)(dst + 8) = w1;
    }
    __syncthreads();
}

constexpr int LDS_BYTES = 147456, MISC_OFF = 131072 + 320;
constexpr int NPH = 3 + NL * 10;
__global__ void __launch_bounds__(512, 2) fwd_kernel(Args a_unused) {
    extern __shared__ __attribute__((aligned(16))) unsigned char lds_raw[];
    LAS unsigned char* lds = (LAS unsigned char*)lds_raw;
    const int tid = threadIdx.x, G = gridDim.x, wv = __builtin_amdgcn_readfirstlane(threadIdx.x >> 6);
    const int wg = (G % 8 == 0) ? (int)(blockIdx.x % 8) * (G / 8) + (int)(blockIdx.x / 8) : (int)blockIdx.x;
    volatile LAS unsigned* MISC = (volatile LAS unsigned*)(lds + MISC_OFF);
    if (tid < 32) MISC[tid] = 0u;
    __syncthreads();
    XcdBarrier bar; bar.bar = nullptr; bar.x = 0; bar.st = nullptr;
    int lo, hi;
    { const Args& a = fresh_args(); unsigned* barw = (unsigned*)(a.ws + WS_CTL) + CW_BAR; bar.bar = barw; lo = a.ph_lo; hi = a.ph_hi;
      if (MK_N_LAUNCHES == 1) bar = xcd_barrier_post(barw, MISC + 8); }
#ifndef PHASE_MASK
#define PHASE_MASK 0xFFFFu
#endif
#define PM(j) (((PHASE_MASK) >> (j)) & 1)
#define IN(k) (lo <= (k) && (k) < hi)
#define SEAM(k) do { if (MK_N_LAUNCHES == 1 && IN((k) + 1)) { XcdBarrier b2_ = bar; asm volatile("" : "+s"(b2_.bar)); xcd_barrier(b2_, wv); if ((REP_MASK >> 15) & 1) xcd_barrier(b2_, wv); } } while (0)
#ifndef MIX_MASK
#define MIX_MASK 7
#endif
#ifndef REP_MASK
#define REP_MASK 0
#endif
#define REPS(j) for (int rep_ = 0; rep_ < 1 + (((REP_MASK) >> (j)) & 1); ++rep_)
#define WSP(T, off) ((T*)(a.ws + (off)))
#define WLP(off) ((const bf16*)(a.ws + WS_W + (size_t)l * WL_STRIDE + (off)))

    if (PM(10) && IN(0)) { REPS(10) { const Args& a = fresh_args(); ph_ada(a, lds, G, wg, wv); __syncthreads(); ph_weights(a, lds, G, wg, wv); } SEAM(0); }
    if (PM(11) && IN(1)) { const Args& a = fresh_args(); ph_ln<0>(a, 0, false, lds, G, wg, wv); SEAM(1); }
#pragma unroll 1
    for (int l = 0; l < NL; ++l) {
        const bool last = (l == NL - 1); const int pb = 3 + l * 10; const int npan = last ? 64 : 72;
        if (PM(0) && IN(pb + 0)) {
            const Args& a = fresh_args();
            SchedIn S{WSP(const bf16, WS_HL), WLP(WL_IN), G, wg, last};
            EpiIn E{WSP(bf16, WS_R1), WSP(bf16, WS_ZT), WSP(const float, WS_ROPE), WSP(const float, WS_ROPE) + 2048 * 32};
            REPS(0) gemm_phase(lds, S, E, wv); if (!last) conv_hole(a, lds, l + 1, 0, 4096, 936, G, wg, wv); SEAM(pb + 0);
        }
        if (PM(1) && IN(pb + 1)) {
            if (MIX_MASK & 1) REPS(12) {
                const Args& a = fresh_args();
                const float lam = WSP(const float, WS_LAM)[l]; const float osc = 1.0f - (0.8f - 0.6f * expf(-0.3f * (float)l));
                const float* subg = a.in[I_SUBLN] + l * 128;
                const bf16* Zb = WSP(const bf16, WS_R1); float* O1b = WSP(float, WS_R2); bf16* Yb = WSP(bf16, WS_Y);
                const int nun = last ? 256 : 288;
                for (int u = wg; u < nun; u += G) {
                    int qrow0, crow0, lrow0, nt, h;
                    if (u < 256) { const int b = u >> 5; h = (u >> 3) & 3; qrow0 = b * 2048 + (u & 7) * 256; crow0 = RL + b * 256; lrow0 = b * 2048; nt = 36; }
                    else { const int q = u - 256, b = q >> 2; h = q & 3; qrow0 = RL + b * 256; crow0 = qrow0; lrow0 = 0; nt = 4; }
                    attn_pass<0>(Zb, O1b, qrow0, crow0, lrow0, 4, nt, h, (LAS char*)lds, wv);
                    attn_pass<1>(Zb, O1b, qrow0, crow0, lrow0, 4, nt, h, (LAS char*)lds, wv);
                    attn_combine(O1b, Yb, qrow0, h, lam, osc, subg, wv);
                }
                __syncthreads();
            }
            if (MIX_MASK & 2) { const Args& a = fresh_args(); SchedFourier S{WSP(const bf16, WS_FLAT), WSP(const bf16, WS_FCTX), WSP(const bf16, WS_ZT), G, wg, last}; EpiStoreBf16 E{WSP(bf16, WS_Y), YC}; REPS(13) gemm_phase(lds, S, E, wv); }
            __syncthreads();
            if (MIX_MASK & 4) REPS(14) { const Args& a = fresh_args(); ph_prep(a, l, last, lds, G, (wg + G - 40) % G, wv); }
            SEAM(pb + 1);
        }
        if (PM(2) && IN(pb + 2)) { const Args& a = fresh_args(); SchedP S{WSP(const bf16, WS_Y), WLP(WL_P), G, wg, npan}; EpiStoreBf16 E{WSP(bf16, WS_R2), PC}; REPS(2) gemm_phase(lds, S, E, wv); SEAM(pb + 2); }
        if (PM(3) && IN(pb + 3)) { const Args& a = fresh_args(); SchedGate S{WSP(const bf16, WS_HL), WLP(WL_G), G, wg, npan}; EpiGate E{WSP(const bf16, WS_R2), WSP(bf16, WS_R1), a.in[I_BGATE] + l * 4096}; REPS(3) gemm_phase(lds, S, E, wv); if (!last) conv_hole(a, lds, l + 1, 4096, 9984, 1152, G, wg, wv); SEAM(pb + 3); }
        if (PM(4) && IN(pb + 4)) { const Args& a = fresh_args(); SchedWo S{WSP(const bf16, WS_R1), WLP(WL_O), G, wg, npan}; EpiF32 E{WSP(float, WS_R2), D}; REPS(4) gemm_phase(lds, S, E, wv); if (!last) conv_hole(a, lds, l + 1, 9984, 17408, 288, G, wg, wv); SEAM(pb + 4); }
        if (PM(5) && IN(pb + 5)) { const Args& a = fresh_args(); if ((REP_MASK >> 5) & 1) { ph_ln<1, true>(a, l, last, lds, G, wg, wv); __syncthreads(); } ph_ln<1>(a, l, last, lds, G, wg, wv); SEAM(pb + 5); }
        if (PM(6) && IN(pb + 6)) { const Args& a = fresh_args(); REPS(6) ph_topk(a, last, lds, G, wg, wv); SEAM(pb + 6); }
        if (PM(7) && IN(pb + 7)) { const Args& a = fresh_args(); SchedE1 S{WSP(const bf16, WS_HL), WLP(WL_GU), WSP(const int, WS_IDX), G, wg, last ? 128 : 144}; EpiSwiglu E{WSP(bf16, WS_R1)}; REPS(7) gemm_phase(lds, S, E, wv); if (!last) conv_hole(a, lds, l + 1, 17408, 22144, 1152, G, wg, wv); SEAM(pb + 7); }
        if (PM(8) && IN(pb + 8)) { const Args& a = fresh_args(); SchedE2 S{WSP(const bf16, WS_R1), WLP(WL_D), G, wg, last ? 128 : 144}; EpiDown E{WSP(bf16, WS_R2 + 72 * MiB), WSP(const float, WS_GV)}; REPS(8) gemm_phase(lds, S, E, wv); if (!last) conv_hole(a, lds, l + 1, 22144, CV_ITEMS, 576, G, wg, wv); SEAM(pb + 8); }
        if (PM(9) && IN(pb + 9)) { const Args& a = fresh_args(); if ((REP_MASK >> 9) & 1) { ph_ln<2, true>(a, l, last, lds, G, wg, wv); __syncthreads(); } ph_ln<2>(a, l, last, lds, G, wg, wv); if (!last) SEAM(pb + 9); }
    }
#undef IN
#undef SEAM
}

extern "C" void kernel_launch(void* const* d_in, const int* in_sizes, int n_in, void* d_out, int out_size, void* d_ws, size_t ws_size, hipStream_t stream) {
    static int grid = 0;
    if (grid == 0) {
        if (n_in != 32 || in_sizes[0] != RL * D || out_size != RL * D || ws_size < WS_END) { fprintf(stderr, "kernel_launch: unexpected shapes (n_in %d, in0 %d, out %d, ws %zu < %zu)\n", n_in, n_in > 0 ? in_sizes[0] : -1, out_size, ws_size, (size_t)WS_END); grid = -1; return; }
        int dev = 0, cus = 0, per_cu = 0;
        if (hipGetDevice(&dev) != hipSuccess || hipDeviceGetAttribute(&cus, hipDeviceAttributeMultiprocessorCount, dev) != hipSuccess) { grid = -1; return; }
        if (hipFuncSetAttribute((const void*)fwd_kernel, hipFuncAttributeMaxDynamicSharedMemorySize, LDS_BYTES) != hipSuccess) { fprintf(stderr, "kernel_launch: hipFuncSetAttribute failed\n"); grid = -1; return; }
        if (hipOccupancyMaxActiveBlocksPerMultiprocessor(&per_cu, (const void*)fwd_kernel, 512, LDS_BYTES) != hipSuccess || per_cu < 1) fprintf(stderr, "kernel_launch: occupancy query says %d\n", per_cu);
        (void)hipGetLastError();
        grid = cus;
    }
    if (grid < 0) return;
    if (hipMemsetAsync((char*)d_ws + WS_CTL, 0, CTL_ZERO_BYTES, stream) != hipSuccess) return;
    Args a{};
    for (int i = 0; i < 32; ++i) a.in[i] = (const float*)d_in[i];
    a.out = (float*)d_out; a.ws = (unsigned char*)d_ws;
#if MK_N_LAUNCHES == 1
    a.ph_lo = 0; a.ph_hi = NPH;
    hipLaunchKernelGGL(fwd_kernel, dim3(grid), dim3(512), LDS_BYTES, stream, a);
#else
    for (int p = 0; p < NPH; ++p) { if (p == 2) continue; a.ph_lo = p; a.ph_hi = p + 1; hipLaunchKernelGGL(fwd_kernel, dim3(grid), dim3(512), LDS_BYTES, stream, a); }
#endif
    const hipError_t le = hipPeekAtLastError();
    if (le != hipSuccess) fprintf(stderr, "kernel_launch: launch failed: %s\n", hipGetErrorName(le));
}
```
